# Optimizing an MI355X kernel written in HIP

```python
import jax, jax.numpy as jnp
from jax import lax
import numpy as np

D_MODEL = 1024
BATCH = 8
SEQ = 8192
DEPTH = 2

N_A_LAYERS = DEPTH // 2
N_B_LAYERS = DEPTH - N_A_LAYERS
CONV_WIDTH = 3
SB_HEADS = 16
SB_HEAD_DIM = D_MODEL // SB_HEADS
Q_BLOCK = 128
PEER_HEADS = 8
PEER_N_KEYS = 128
PEER_N_EXPERTS = PEER_N_KEYS * PEER_N_KEYS
PEER_KEY_DIM = 128
PEER_QUERY_DIM = 2 * PEER_KEY_DIM
PEER_TOPK = 16
TOKEN_CHUNK = 128
RMS_EPS = 1e-6

kernel_name = "yoco_shortconv_stickbreaking_peer"


def rmsnorm(x, g):
    xf = x.astype(jnp.float32)
    y = xf * lax.rsqrt(jnp.mean(xf * xf, axis=-1, keepdims=True) + RMS_EPS)
    return (y * g.astype(jnp.float32)).astype(x.dtype)


def short_conv_mixer(xn, w_in, conv_k, w_out):
    L = xn.shape[1]
    b_gate, c_gate, h = jnp.split(xn @ w_in, 3, axis=-1)
    u = c_gate * h
    up = jnp.pad(u, ((0, 0), (CONV_WIDTH - 1, 0), (0, 0)))
    conv = up[:, 0:L] * conv_k[0]
    for i in range(1, CONV_WIDTH):
        conv = conv + up[:, i:i + L] * conv_k[i]
    return (b_gate * conv) @ w_out


def stick_breaking_attention(q, k, v):
    B, S, H, Dh = q.shape
    nb = S // Q_BLOCK
    scale = Dh ** -0.5
    q_blocks = q.reshape(B, nb, Q_BLOCK, H, Dh).transpose(1, 0, 3, 2, 4)
    k_pos = jnp.arange(S)

    def one_block(args):
        q_blk, blk = args
        z = jnp.einsum('bhqd,bhkd->bhqk', q_blk, k).astype(jnp.float32) * scale
        q_pos = blk * Q_BLOCK + jnp.arange(Q_BLOCK)
        causal = k_pos[None, :] < q_pos[:, None]
        log_not = jnp.where(causal, jax.nn.log_sigmoid(-z), 0.0)
        after = lax.cumsum(log_not, axis=3, reverse=True) - log_not
        w = jnp.where(causal, jnp.exp(jax.nn.log_sigmoid(z) + after), 0.0)
        return jnp.einsum('bhqk,bhkd->bhqd', w.astype(v.dtype), v)

    out = lax.map(one_block, (q_blocks, jnp.arange(nb)))
    return out.transpose(1, 0, 3, 2, 4).reshape(B, S, H * Dh)


def peer_ffn(xn, w_query, subkeys, u_tbl, v_tbl):
    B, S, D = xn.shape
    tok = xn.reshape(-1, TOKEN_CHUNK, D)

    def one_chunk(xc):
        C = xc.shape[0]
        q = (xc @ w_query).reshape(C, PEER_HEADS, 2, PEER_KEY_DIM)
        s = jnp.einsum('chpd,hpnd->chpn', q, subkeys).astype(jnp.float32)
        s1, i1 = lax.top_k(s[:, :, 0], PEER_TOPK)
        s2, i2 = lax.top_k(s[:, :, 1], PEER_TOPK)
        cand = (s1[..., :, None] + s2[..., None, :]).reshape(C, PEER_HEADS, PEER_TOPK * PEER_TOPK)
        top_s, top_c = lax.top_k(cand, PEER_TOPK)
        idx = (jnp.take_along_axis(i1, top_c // PEER_TOPK, axis=-1) * PEER_N_KEYS
               + jnp.take_along_axis(i2, top_c % PEER_TOPK, axis=-1))
        gate = jax.nn.softmax(top_s, axis=-1)
        act = jax.nn.gelu(jnp.einsum('chkd,cd->chk', u_tbl[idx], xc).astype(jnp.float32), approximate=False)
        coef = (gate * act).astype(xc.dtype)
        return jnp.einsum('chk,chkd->cd', coef, v_tbl[idx])

    return lax.map(one_chunk, tok).reshape(B, S, D)


def setup_inputs(seed: int = 0) -> dict:
    key = jax.random.key(seed)
    ks = jax.random.split(key, 16)
    D = D_MODEL
    f32 = jnp.float32
    nrm = lambda k, shape, s: jax.random.normal(k, shape, f32) * s
    return {
        "x": nrm(ks[0], (BATCH, SEQ, D), 1.0),
        "norm_mix": 1.0 + nrm(ks[1], (DEPTH, D), 0.02),
        "norm_ffn": 1.0 + nrm(ks[2], (DEPTH, D), 0.02),
        "conv_w_in": nrm(ks[3], (N_A_LAYERS, D, 3 * D), D ** -0.5),
        "conv_kernel": nrm(ks[4], (N_A_LAYERS, CONV_WIDTH, D), CONV_WIDTH ** -0.5),
        "conv_w_out": nrm(ks[5], (N_A_LAYERS, D, D), D ** -0.5),
        "norm_kv": 1.0 + nrm(ks[6], (D,), 0.02),
        "w_kv": nrm(ks[7], (D, 2 * SB_HEADS * SB_HEAD_DIM), D ** -0.5),
        "attn_w_q": nrm(ks[8], (N_B_LAYERS, D, SB_HEADS * SB_HEAD_DIM), D ** -0.5),
        "attn_w_o": nrm(ks[9], (N_B_LAYERS, SB_HEADS * SB_HEAD_DIM, D), D ** -0.5),
        "peer_w_query": nrm(ks[10], (DEPTH, D, PEER_HEADS * PEER_QUERY_DIM), D ** -0.5),
        "peer_subkeys": nrm(ks[11], (DEPTH, PEER_HEADS, 2, PEER_N_KEYS, PEER_KEY_DIM), PEER_KEY_DIM ** -0.5),
        "peer_u": nrm(ks[12], (DEPTH, PEER_N_EXPERTS, D), D ** -0.5),
        "peer_v": nrm(ks[13], (DEPTH, PEER_N_EXPERTS, D), PEER_HEADS ** -0.5),
        "norm_final": 1.0 + nrm(ks[14], (D,), 0.02),
    }


def reference(x, norm_mix, norm_ffn, conv_w_in, conv_kernel, conv_w_out, norm_kv, w_kv,
              attn_w_q, attn_w_o, peer_w_query, peer_subkeys, peer_u, peer_v, norm_final):
    B, S, D = x.shape
    h = x
    k_shared = None
    v_shared = None
    for layer in range(DEPTH):
        xn = rmsnorm(h, norm_mix[layer])
        if layer < N_A_LAYERS:
            h = h + short_conv_mixer(xn, conv_w_in[layer], conv_kernel[layer], conv_w_out[layer])
        else:
            j = layer - N_A_LAYERS
            q = (xn @ attn_w_q[j]).reshape(B, S, SB_HEADS, SB_HEAD_DIM)
            h = h + stick_breaking_attention(q, k_shared, v_shared) @ attn_w_o[j]
        h = h + peer_ffn(rmsnorm(h, norm_ffn[layer]), peer_w_query[layer], peer_subkeys[layer],
                         peer_u[layer], peer_v[layer])
        if layer == N_A_LAYERS - 1:
            k_flat, v_flat = jnp.split(rmsnorm(h, norm_kv) @ w_kv, 2, axis=-1)
            k_shared = k_flat.reshape(B, S, SB_HEADS, SB_HEAD_DIM).transpose(0, 2, 1, 3)
            v_shared = v_flat.reshape(B, S, SB_HEADS, SB_HEAD_DIM).transpose(0, 2, 1, 3)
    return rmsnorm(h, norm_final)
```

```cpp
#include <hip/hip_runtime.h>
#include <cstdio>
#include <cstdint>
#include <type_traits>
namespace pg8 {
#define PG8_LAS __attribute__((address_space(3)))
typedef unsigned short bf16_t;
typedef short bf16x8 __attribute__((ext_vector_type(8)));
typedef float f32x4 __attribute__((ext_vector_type(4)));
typedef unsigned u32x4 __attribute__((ext_vector_type(4)));
constexpr int BM = 256, BK = 64, HALF = 128, HTB = HALF * BK * 2  , STAGE_BYTES = 8 * HTB, NXCD = 8, WGM = 8;

__host__ __device__ __forceinline__ int lds_byte(int r, int c) { const int st = (r >> 4) * 2 + (c >> 5), rr = r & 15, cc = c & 31, ob = rr * 64 + cc * 2; return st * 1024 + (ob ^ (((ob >> 9) & 1) << 5)); }
__host__ __device__ __forceinline__ void stage_rc(int b, int& R, int& C) { const int st = b / 1024, sb = b % 1024, swz = sb ^ (((sb >> 9) & 1) << 5); R = (st >> 1) * 16 + swz / 64; C = (st & 1) * 32 + (swz % 64) / 2; }
__host__ __device__ __forceinline__ int perm32(int rho) { const int n = rho >> 4, i = rho & 15; return 8 * (i >> 2) + 4 * n + (i & 3); }

struct Unit { int pm, pn; };
struct Gemm { const bf16_t* A; const bf16_t* Bt; int M, N, K; };

struct StaticOrder {
    int nM, nN, nwg, G, c;
    __host__ __device__ void init(int M, int N, int G_, int c_) { nM = M / BM; nN = N / BM; nwg = nM * nN; G = G_; c = c_; }
    __host__ __device__ bool next(int i, Unit& u) const {
        const long L = (long)i * G + c; if (L >= nwg) return false;
        int wgid = (int)L; { const int q = nwg / NXCD, r = nwg % NXCD, xcd = wgid % NXCD, off = wgid / NXCD; wgid = (xcd < r ? xcd * (q + 1) : r * (q + 1) + (xcd - r) * q) + off; }
        const int nig = WGM * nN, gid = wgid / nig, fm = gid * WGM, gsz = (nM - fm) < WGM ? (nM - fm) : WGM;
        u.pm = fm + ((wgid % nig) % gsz); u.pn = (wgid % nig) / gsz; return true;
    }
    __device__ __forceinline__ void a_ready(const Unit&) const {}
    __device__ __forceinline__ void done(const Unit&) const {}
};

__device__ __forceinline__ unsigned cvt_pk_f16(float lo, float hi) { typedef _Float16 h2_t __attribute__((ext_vector_type(2))); const h2_t t = (h2_t){(_Float16)lo, (_Float16)hi}; return __builtin_bit_cast(unsigned, t); }
__device__ __forceinline__ unsigned cvt_pk_bf16(float lo, float hi) { unsigned r; asm volatile("v_cvt_pk_bf16_f32 %0, %1, %2" : "=v"(r) : "v"(lo), "v"(hi)); return r; }
typedef float f32x2 __attribute__((ext_vector_type(2)));

struct EpiBf16 {
    static constexpr bool PERM = true, AFTER_DRAIN = false;
    bf16_t* O; int ldc; int split_cols; size_t split_stride; float scale0; const float* rs; int ssq4; int f16out;
    __device__ __forceinline__ void operator()(const f32x4 (&acc)[2][2][4][2], const Unit& u, int wr, int wc, int fr, int fq) const {
        const int row0 = u.pm * BM + wr * 64 + fr; int colt = u.pn * BM; bf16_t* base = O;
        float sc = 1.f; if (split_cols) { const int t = colt / split_cols; base += (size_t)t * split_stride; colt -= t * split_cols; if (t == 0) sc = scale0; }
        const int col0 = colt + wc * 32 + 8 * fq;
#pragma unroll
        for (int ai = 0; ai < 2; ++ai)
#pragma unroll
            for (int m = 0; m < 4; ++m) { bf16_t* rowp = base + (size_t)(row0 + ai * HALF + m * 16) * ldc + col0; float scr = sc;
                if (rs) { const int rr = row0 + ai * HALF + m * 16; if (ssq4) { const f32x4 q = *(const f32x4*)(rs + 4 * (size_t)rr); scr = sc / sqrtf(((q[0] + q[1]) + (q[2] + q[3])) * (1.f / 1024.f) + 1e-6f); } else scr = sc * rs[rr]; }
#pragma unroll
                for (int bj = 0; bj < 2; ++bj) { const f32x4 v0 = acc[ai][bj][m][0] * scr, v1 = acc[ai][bj][m][1] * scr;
                    u32x4 w;
                    if (f16out) { w.x = cvt_pk_f16(v0[0], v0[1]); w.y = cvt_pk_f16(v0[2], v0[3]); w.z = cvt_pk_f16(v1[0], v1[1]); w.w = cvt_pk_f16(v1[2], v1[3]); }
                    else { w.x = cvt_pk_bf16(v0[0], v0[1]); w.y = cvt_pk_bf16(v0[2], v0[3]); w.z = cvt_pk_bf16(v1[0], v1[1]); w.w = cvt_pk_bf16(v1[2], v1[3]); }
                    *(u32x4*)(rowp + bj * HALF) = w; } }
    }
};
struct EpiConvIn {
    static constexpr bool PERM = true, AFTER_DRAIN = false;
    bf16_t* Bo; bf16_t* Uo; const float* rs;
    __device__ __forceinline__ void operator()(const f32x4 (&acc)[2][2][4][2], const Unit& u, int wr, int wc, int fr, int fq) const {
        const int row0 = u.pm * BM + wr * 64 + fr;
        if (u.pn < 4) { const int col0 = u.pn * BM + wc * 32 + 8 * fq;
#pragma unroll
            for (int ai = 0; ai < 2; ++ai)
#pragma unroll
                for (int m = 0; m < 4; ++m) { bf16_t* rowp = Bo + (size_t)(row0 + ai * HALF + m * 16) * 1024 + col0; const float r = rs[row0 + ai * HALF + m * 16];
#pragma unroll
                    for (int bj = 0; bj < 2; ++bj) { const f32x4 v0 = acc[ai][bj][m][0] * r, v1 = acc[ai][bj][m][1] * r;
                        u32x4 w; w.x = cvt_pk_bf16(v0[0], v0[1]); w.y = cvt_pk_bf16(v0[2], v0[3]); w.z = cvt_pk_bf16(v1[0], v1[1]); w.w = cvt_pk_bf16(v1[2], v1[3]);
                        *(u32x4*)(rowp + bj * HALF) = w; } }
        } else { const int col0 = (u.pn - 4) * HALF + wc * 32 + 8 * fq;
#pragma unroll
            for (int ai = 0; ai < 2; ++ai)
#pragma unroll
                for (int m = 0; m < 4; ++m) { const float r = rs[row0 + ai * HALF + m * 16], r2 = r * r; const f32x4 v0 = acc[ai][0][m][0] * acc[ai][1][m][0] * r2, v1 = acc[ai][0][m][1] * acc[ai][1][m][1] * r2;
                    u32x4 w; w.x = cvt_pk_bf16(v0[0], v0[1]); w.y = cvt_pk_bf16(v0[2], v0[3]); w.z = cvt_pk_bf16(v1[0], v1[1]); w.w = cvt_pk_bf16(v1[2], v1[3]);
                    *(u32x4*)(Uo + (size_t)(row0 + ai * HALF + m * 16) * 1024 + col0) = w; }
        }
    }
};
template <bool RF32> struct EpiBf16Res {
    static constexpr bool PERM = true, AFTER_DRAIN = false;
    const void* R; bf16_t* O; int ldc;
    __device__ __forceinline__ void operator()(const f32x4 (&acc)[2][2][4][2], const Unit& u, int wr, int wc, int fr, int fq) const {
        const int row0 = u.pm * BM + wr * 64 + fr, col0 = u.pn * BM + wc * 32 + 8 * fq;
#pragma unroll
        for (int ai = 0; ai < 2; ++ai)
#pragma unroll
            for (int m = 0; m < 4; ++m) { const size_t off = (size_t)(row0 + ai * HALF + m * 16) * ldc + col0;
                f32x4 r0[2], r1[2];
#pragma unroll
                for (int bj = 0; bj < 2; ++bj) {
                    if (RF32) { r0[bj] = *(const f32x4*)((const float*)R + off + bj * HALF); r1[bj] = *(const f32x4*)((const float*)R + off + bj * HALF + 4); }
                    else { const u32x4 w = *(const u32x4*)((const bf16_t*)R + off + bj * HALF);
                        r0[bj] = (f32x4){__uint_as_float(w.x << 16), __uint_as_float(w.x & 0xffff0000u), __uint_as_float(w.y << 16), __uint_as_float(w.y & 0xffff0000u)};
                        r1[bj] = (f32x4){__uint_as_float(w.z << 16), __uint_as_float(w.z & 0xffff0000u), __uint_as_float(w.w << 16), __uint_as_float(w.w & 0xffff0000u)}; } }
#pragma unroll
                for (int bj = 0; bj < 2; ++bj) { const f32x4 v0 = acc[ai][bj][m][0] + r0[bj], v1 = acc[ai][bj][m][1] + r1[bj];
                    u32x4 w; w.x = cvt_pk_bf16(v0[0], v0[1]); w.y = cvt_pk_bf16(v0[2], v0[3]); w.z = cvt_pk_bf16(v1[0], v1[1]); w.w = cvt_pk_bf16(v1[2], v1[3]);
                    *(u32x4*)(O + off + bj * HALF) = w; }
                if (m & 1) asm volatile("" ::: "memory"); }
    }
};

template <class Epi, class Sched, bool ALIGN_EPI = false, bool SP2 = false>
__device__ __forceinline__ void gemm_phase(PG8_LAS unsigned char* lds, const Gemm g, const Sched& S, const Epi& E) {
    const int tid = threadIdx.x, wid = __builtin_amdgcn_readfirstlane(tid >> 6), lane = tid & 63, wr = wid >> 2, wc = wid & 3, fr = lane & 15, fq = lane >> 4;
    const int K = g.K, nt = K / BK;
    unsigned voffA[2], voffB[2];
#pragma unroll
    for (int i = 0; i < 2; ++i) { int R, C; stage_rc(tid * 16 + i * 8192, R, C); const int Rb = Epi::PERM ? ((R & ~31) + perm32(R & 31)) : R;
        voffA[i] = (unsigned)(R * K + C) * 2u; voffB[i] = (unsigned)(Rb * K + C) * 2u; }
    const size_t kstep = (size_t)(BK * 2);
    const size_t hstep = (size_t)HALF * K * 2;
    const size_t tstep = 2 * hstep;
    const unsigned ldsw = (unsigned)wid * 1024u;
    const int aoff = lds_byte(wr * 64 + fr, fq * 8), boff = lds_byte(wc * 32 + fr, fq * 8);
#define PG8_SA(b, h) (((b) * 2 + (h)) * HTB)
#define PG8_SB(b, h) ((4 + (b) * 2 + (h)) * HTB)
#define PG8_STAGE(bufoff, gbase, voff) do { _Pragma("unroll") for (int _i = 0; _i < 2; ++_i) \
        __builtin_amdgcn_global_load_lds((const unsigned*)((const char*)(gbase) + (voff)[_i]), (PG8_LAS unsigned*)(lds + (bufoff) + ldsw + _i * 8192), 16, 0, 0); } while (0)
#define PG8_LDA(dst, b, h) do { _Pragma("unroll") for (int m = 0; m < 4; ++m) _Pragma("unroll") for (int k = 0; k < 2; ++k) dst[m][k] = *(const PG8_LAS bf16x8*)(lds + PG8_SA(b, h) + aoff + m * 2048 + k * 1024); } while (0)
#define PG8_LDB(dst, b, h) do { _Pragma("unroll") for (int n = 0; n < 2; ++n) _Pragma("unroll") for (int k = 0; k < 2; ++k) dst[n][k] = *(const PG8_LAS bf16x8*)(lds + PG8_SB(b, h) + boff + n * 2048 + k * 1024); } while (0)
#define PG8_MMA(ai, bj, At, Bt) do { __builtin_amdgcn_s_setprio(1); _Pragma("unroll") for (int m = 0; m < 4; ++m) _Pragma("unroll") for (int n = 0; n < 2; ++n) _Pragma("unroll") for (int k = 0; k < 2; ++k) \
        acc[ai][bj][m][n] = __builtin_amdgcn_mfma_f32_16x16x32_bf16(Bt[n][k], At[m][k], acc[ai][bj][m][n], 0, 0, 0); __builtin_amdgcn_s_setprio(0); } while (0)
#define PG8_WAIT_V(n) asm volatile("s_waitcnt vmcnt(" #n ")" ::: "memory")
#define PG8_WAIT_L(n) asm volatile("s_waitcnt lgkmcnt(" #n ")" ::: "memory")
#define PG8_BAR __builtin_amdgcn_s_barrier()
#define PG8_SCHED __builtin_amdgcn_sched_barrier(0)
    Unit cur, nxt; int ui = 0;
    if (!S.next(0, cur)) return;
    f32x4 acc[2][2][4][2];
#pragma unroll
    for (int a = 0; a < 2; ++a)
#pragma unroll
        for (int b = 0; b < 2; ++b)
#pragma unroll
            for (int m = 0; m < 4; ++m)
#pragma unroll
                for (int n = 0; n < 2; ++n) acc[a][b][m][n] = (f32x4){0.f, 0.f, 0.f, 0.f};
    bf16x8 At[4][2], B0[2][2], B1[2][2];
    const char* cA = (const char*)g.A + (size_t)cur.pm * tstep; const char* cB = (const char*)g.Bt + (size_t)cur.pn * tstep;
    S.a_ready(cur);
    if constexpr (SP2) {
        PG8_STAGE(PG8_SB(0, 0), cB, voffB); PG8_STAGE(PG8_SB(0, 1), cB + hstep, voffB); PG8_STAGE(PG8_SA(0, 0), cA, voffA); PG8_STAGE(PG8_SA(0, 1), cA + hstep, voffA);
        if (wr == 1) PG8_BAR;
        PG8_WAIT_V(2); PG8_BAR;
        PG8_STAGE(PG8_SB(1, 0), cB + kstep, voffB); PG8_STAGE(PG8_SA(1, 0), cA + kstep, voffA); PG8_STAGE(PG8_SB(1, 1), cB + hstep + kstep, voffB);
        PG8_WAIT_V(6); PG8_BAR;
    } else {
        PG8_STAGE(PG8_SB(0, 0), cB, voffB); PG8_STAGE(PG8_SA(0, 0), cA, voffA); PG8_STAGE(PG8_SB(0, 1), cB + hstep, voffB); PG8_STAGE(PG8_SA(0, 1), cA + hstep, voffA);
        if (wr == 1) PG8_BAR;
        PG8_WAIT_V(4); PG8_BAR;
        PG8_STAGE(PG8_SB(1, 0), cB + kstep, voffB); PG8_STAGE(PG8_SA(1, 0), cA + kstep, voffA); PG8_STAGE(PG8_SB(1, 1), cB + hstep + kstep, voffB);
        PG8_WAIT_V(6); PG8_BAR;
    }
    for (;;) {
        const bool has_next = S.next(ui + 1, nxt);
        const char* nA = has_next ? (const char*)g.A + (size_t)nxt.pm * tstep : cA; const char* nB = has_next ? (const char*)g.Bt + (size_t)nxt.pn * tstep : cB;
        for (int t = 0; t < nt; t += 2) {
            const bool last = (t == nt - 2);
            const char* a1 = cA + (size_t)(t + 1) * kstep;
            const char* a2 = last ? nA : cA + (size_t)(t + 2) * kstep; const char* b2 = last ? nB : cB + (size_t)(t + 2) * kstep;
            const char* a3 = a2 + kstep; const char* b3 = b2 + kstep;
            if (last && has_next) S.a_ready(nxt);
            if constexpr (SP2) {
            PG8_LDB(B0, 0, 0); PG8_LDB(B1, 0, 1); PG8_SCHED; PG8_LDA(At, 0, 0); PG8_STAGE(PG8_SA(1, 1), a1 + hstep, voffA);
            PG8_WAIT_V(8); PG8_WAIT_L(0); PG8_BAR; PG8_MMA(0, 0, At, B0); PG8_MMA(0, 1, At, B1); PG8_BAR; PG8_SCHED;
            PG8_LDA(At, 0, 1); PG8_STAGE(PG8_SB(0, 0), b2, voffB); PG8_STAGE(PG8_SB(0, 1), b2 + hstep, voffB); PG8_STAGE(PG8_SA(0, 0), a2, voffA);
            PG8_WAIT_V(8); PG8_WAIT_L(0); PG8_BAR; PG8_MMA(1, 0, At, B0); PG8_MMA(1, 1, At, B1); PG8_BAR; PG8_SCHED;
            PG8_LDB(B0, 1, 0); PG8_LDB(B1, 1, 1); PG8_SCHED; PG8_LDA(At, 1, 0); PG8_STAGE(PG8_SA(0, 1), a2 + hstep, voffA);
            PG8_WAIT_V(8); PG8_WAIT_L(0); PG8_BAR; PG8_MMA(0, 0, At, B0); PG8_MMA(0, 1, At, B1); PG8_BAR; PG8_SCHED;
            PG8_LDA(At, 1, 1); PG8_STAGE(PG8_SB(1, 0), b3, voffB); PG8_STAGE(PG8_SB(1, 1), b3 + hstep, voffB); PG8_STAGE(PG8_SA(1, 0), a3, voffA);
            PG8_WAIT_V(8); PG8_WAIT_L(0); PG8_BAR; PG8_MMA(1, 0, At, B0); PG8_MMA(1, 1, At, B1); PG8_BAR; PG8_SCHED;
            } else {
            PG8_LDB(B0, 0, 0); PG8_SCHED; PG8_LDA(At, 0, 0); PG8_STAGE(PG8_SA(1, 1), a1 + hstep, voffA);
            PG8_WAIT_L(8); PG8_BAR; PG8_WAIT_L(0); PG8_MMA(0, 0, At, B0); PG8_BAR; PG8_SCHED;
            PG8_LDB(B1, 0, 1); PG8_STAGE(PG8_SB(0, 0), b2, voffB);
            PG8_BAR; PG8_WAIT_L(0); PG8_MMA(0, 1, At, B1); PG8_BAR;
            PG8_LDA(At, 0, 1); PG8_STAGE(PG8_SA(0, 0), a2, voffA);
            PG8_BAR; PG8_WAIT_L(0); PG8_MMA(1, 0, At, B0); PG8_BAR; PG8_SCHED;
            PG8_STAGE(PG8_SB(0, 1), b2 + hstep, voffB);
            PG8_WAIT_V(6); PG8_BAR; PG8_MMA(1, 1, At, B1); PG8_BAR;
            PG8_LDB(B0, 1, 0); PG8_SCHED; PG8_LDA(At, 1, 0); PG8_STAGE(PG8_SA(0, 1), a2 + hstep, voffA);
            PG8_WAIT_L(8); PG8_BAR; PG8_WAIT_L(0); PG8_MMA(0, 0, At, B0); PG8_BAR; PG8_SCHED;
            PG8_LDB(B1, 1, 1); PG8_STAGE(PG8_SB(1, 0), b3, voffB);
            PG8_BAR; PG8_WAIT_L(0); PG8_MMA(0, 1, At, B1); PG8_BAR;
            PG8_LDA(At, 1, 1); PG8_STAGE(PG8_SA(1, 0), a3, voffA);
            PG8_BAR; PG8_WAIT_L(0); PG8_MMA(1, 0, At, B0); PG8_BAR; PG8_SCHED;
            PG8_STAGE(PG8_SB(1, 1), b3 + hstep, voffB);
            PG8_WAIT_V(6); PG8_BAR; PG8_MMA(1, 1, At, B1); PG8_BAR;
            }
        }
        if constexpr (ALIGN_EPI) { if (wr == 0) PG8_BAR; }
        if constexpr (!Epi::AFTER_DRAIN) { E(acc, cur, wr, wc, fr, fq); S.done(cur); }
        if (!has_next) break;
#pragma unroll
        for (int a = 0; a < 2; ++a)
#pragma unroll
            for (int b = 0; b < 2; ++b)
#pragma unroll
                for (int m = 0; m < 4; ++m)
#pragma unroll
                    for (int n = 0; n < 2; ++n) acc[a][b][m][n] = (f32x4){0.f, 0.f, 0.f, 0.f};
        cur = nxt; cA = nA; cB = nB; ++ui;
        if constexpr (ALIGN_EPI) { if (wr == 1) PG8_BAR; }
    }
    PG8_WAIT_V(0);
    if constexpr (!ALIGN_EPI) { if (wr == 0) PG8_BAR; }
    PG8_BAR;
    if constexpr (Epi::AFTER_DRAIN) { E.fused(acc, cur, wr, wc, fr, fq, lds, wid, lane); S.done(cur); }
#undef PG8_SA
#undef PG8_SB
#undef PG8_STAGE
#undef PG8_LDA
#undef PG8_LDB
#undef PG8_MMA
#undef PG8_WAIT_V
#undef PG8_WAIT_L
#undef PG8_BAR
#undef PG8_SCHED
}
}

constexpr int NB = 8, SEQ = 8192, D = 1024, M = NB * SEQ;
constexpr int NH = 16, HD = 64;
constexpr int PH = 8, NKEYS = 128, KD = 128, TOPK = 16, NEXP = NKEYS * NKEYS, QPW = PH * 2 * KD;
constexpr float RMS_EPS = 1e-6f;
constexpr int NWAVES = 8;

constexpr size_t MiB = 1u << 20;
constexpr size_t WS_CTL = 0, CTL_ZERO_BYTES = 1 * MiB;
constexpr size_t WS_W1 = 1 * MiB;
constexpr size_t WS_W2 = 7 * MiB;
constexpr size_t WS_WQ0 = 9 * MiB;
constexpr size_t WS_WQKV = 13 * MiB;
constexpr size_t WS_WO = 19 * MiB;
constexpr size_t WS_WQ1 = 21 * MiB;
constexpr size_t WS_SK = 25 * MiB;
constexpr size_t WS_UQ = 32 * MiB;
constexpr size_t WS_VQ = 64 * MiB;
constexpr size_t WS_SU = 96 * MiB, WS_SV = 96 * MiB + 256 * 1024;
constexpr size_t WS_XQ = 98 * MiB;
constexpr size_t WS_SX = 162 * MiB;
constexpr size_t WS_IDX = 163 * MiB;
constexpr size_t WS_GATE = 179 * MiB;
constexpr size_t WS_ACT = 211 * MiB;
constexpr size_t WS_SSQ4 = 244 * MiB;
constexpr size_t WS_XN = 256 * MiB;
constexpr size_t WS_BIG = 384 * MiB;
constexpr size_t WS_HB = 768 * MiB;
constexpr size_t WS_END = 896 * MiB;
constexpr int CW_BAR = 4096;

constexpr int RING_OFF = 0, RING_BYTES = 131072;
constexpr int LDSCTL_OFF = RING_BYTES, MISC_OFF = LDSCTL_OFF + 320;
constexpr int LDS_BYTES = 147456;
static_assert(MISC_OFF + 128 <= LDS_BYTES, "LDS map");

#define GAS __attribute__((address_space(1)))
#define LAS __attribute__((address_space(3)))
typedef unsigned short bf16;
typedef unsigned v4u __attribute__((ext_vector_type(4)));
typedef unsigned v2u __attribute__((ext_vector_type(2)));
typedef float f32x4 __attribute__((ext_vector_type(4)));
typedef float f32x16 __attribute__((ext_vector_type(16)));
typedef short bf16x8 __attribute__((ext_vector_type(8)));
typedef short s16x4 __attribute__((ext_vector_type(4)));
typedef __bf16 bf2_t __attribute__((ext_vector_type(2)));
typedef GAS unsigned gu32;
#define RLX_AGENT __ATOMIC_RELAXED, __HIP_MEMORY_SCOPE_AGENT
#define LDS_WAIT() asm volatile("s_waitcnt lgkmcnt(0)" ::: "memory")
#define VM_WAIT() asm volatile("s_waitcnt vmcnt(0)" ::: "memory")
__device__ __forceinline__ unsigned f2bf(float f) { unsigned u = __builtin_bit_cast(unsigned, f); return (u + 0x7fffu + ((u >> 16) & 1u)) >> 16; }
__device__ __forceinline__ unsigned pk2(float lo, float hi) { return f2bf(lo) | (f2bf(hi) << 16); }
__device__ __forceinline__ float bflo(unsigned w) { return __uint_as_float(w << 16); }
__device__ __forceinline__ float bfhi(unsigned w) { return __uint_as_float(w & 0xffff0000u); }

#define XB_TMO      128
#define XB_XCNT(j)  (256  + 64 * (j))
#define XB_XSUB(j)  (1280 + 64 * (j))
#define XB_XGEN(j)  (2304 + 64 * (j))
#define XB_TOP      3328
#define XB_TOPGEN   3392
#define XCD_BAR_WORDS 3456
#define XB_SPIN_CAP (1u << 18)

__device__ __forceinline__ unsigned xb_ld(unsigned* p)              { return __hip_atomic_load(p, __ATOMIC_RELAXED, __HIP_MEMORY_SCOPE_AGENT); }
__device__ __forceinline__ unsigned xb_add(unsigned* p, unsigned v) { return __hip_atomic_fetch_add(p, v, __ATOMIC_RELAXED, __HIP_MEMORY_SCOPE_AGENT); }
__device__ __forceinline__ unsigned xb_xcc_id() { return (unsigned)__builtin_amdgcn_s_getreg((3 << 11) | 20) & 0xFu; }
#define XB_SPIN(cond, bar) do { unsigned _sp = 0; while (cond) { __builtin_amdgcn_s_sleep(1); \
    if ((++_sp & 255u) == 0u) { if (xb_ld(&(bar)[XB_TMO])) break; if (_sp > XB_SPIN_CAP) { atomicAdd(&(bar)[XB_TMO], 1u); break; } } } } while (0)

struct XcdBarrier {
    unsigned* bar; unsigned x;
    volatile LAS unsigned* st;
};

__device__ __forceinline__ XcdBarrier xcd_barrier_post(unsigned* bar, volatile LAS unsigned* st) {
    XcdBarrier b; b.bar = bar; b.x = xb_xcc_id(); b.st = st;
    if (threadIdx.x == 0) (void)xb_add(&bar[XB_XCNT(b.x)], 1u);
    return b;
}
__device__ __forceinline__ void xcd_barrier_complete(unsigned* bar, unsigned x, unsigned& nloc, unsigned& nx) {
    const unsigned G = gridDim.x * gridDim.y * gridDim.z;
    unsigned sum, cnt, mine, sp = 0u;
    for (;;) {
        sum = 0u; cnt = 0u; mine = 0u;
#pragma unroll
        for (unsigned j = 0; j < 16; ++j) { const unsigned c = xb_ld(&bar[XB_XCNT(j)]); sum += c; cnt += (c > 0u) ? 1u : 0u; mine = (j == x) ? c : mine; }
        if (sum == G) break;
        __builtin_amdgcn_s_sleep(1);
        if ((++sp & 255u) == 0u) { if (xb_ld(&bar[XB_TMO])) break; if (sp > XB_SPIN_CAP) { atomicAdd(&bar[XB_TMO], 1u); break; } }
    }
    nloc = mine > 0u ? mine : 1u; nx = cnt > 0u ? cnt : 1u;
}

__device__ __forceinline__ void xcd_barrier(const XcdBarrier& b) {
    asm volatile("s_waitcnt vmcnt(0)" ::: "memory");
    __syncthreads();
    if (threadIdx.x == 0) {
        unsigned* bar = b.bar;
        __builtin_amdgcn_s_waitcnt(0);
        unsigned nloc = b.st[0], nx = b.st[1];
        if (nloc == 0u) { xcd_barrier_complete(bar, b.x, nloc, nx); b.st[0] = nloc; b.st[1] = nx; }
        const unsigned old = xb_add(&bar[XB_XSUB(b.x)], 1u);
        const unsigned gen = old / nloc;
        if (old + 1u == (gen + 1u) * nloc) {
            __builtin_amdgcn_fence(__ATOMIC_RELEASE, "agent");
            asm volatile("s_waitcnt vmcnt(0)" ::: "memory");
            const unsigned og = xb_add(&bar[XB_TOP], 1u);
            const unsigned tg = og / nx;
            if (og + 1u == (tg + 1u) * nx) xb_add(&bar[XB_TOPGEN], 1u);
            else XB_SPIN(xb_ld(&bar[XB_TOPGEN]) == tg, bar);
            __builtin_amdgcn_fence(__ATOMIC_ACQUIRE, "agent");
            xb_add(&bar[XB_XGEN(b.x)], 1u);
            asm volatile("s_waitcnt vmcnt(0)" ::: "memory");
        } else {
            XB_SPIN(xb_ld(&bar[XB_XGEN(b.x)]) == gen, bar);
            __builtin_amdgcn_fence(__ATOMIC_ACQUIRE, "agent");
            asm volatile("s_waitcnt vmcnt(0)" ::: "memory");
        }
    }
    __syncthreads();
}

__device__ __forceinline__ float wave_sum(float v) {
#pragma unroll
    for (int o = 1; o < 64; o <<= 1) v += __shfl_xor(v, o);
    return v;
}
__device__ __forceinline__ float row16_sum(float s) {
    s += __builtin_amdgcn_update_dpp(0.f, s, 0xB1, 0xF, 0xF, true);
    s += __builtin_amdgcn_update_dpp(0.f, s, 0x4E, 0xF, 0xF, true);
    s += __builtin_amdgcn_update_dpp(0.f, s, 0x141, 0xF, 0xF, true);
    s += __builtin_amdgcn_update_dpp(0.f, s, 0x140, 0xF, 0xF, true);
    return s;
}
__device__ __forceinline__ float fmax_s(float a, float b) { float r; asm("v_max_f32_e32 %0, %1, %2" : "=v"(r) : "v"(a), "v"(b)); return r; }
__device__ __forceinline__ float fmin_s(float a, float b) { float r; asm("v_min_f32_e32 %0, %1, %2" : "=v"(r) : "v"(a), "v"(b)); return r; }
__device__ __forceinline__ float opq(float x) { asm("" : "+v"(x)); return x; }
__device__ __forceinline__ int opq(int x) { asm("" : "+v"(x)); return x; }
#define CE_DESC(a, b) do { const float _h = fmax_s(a, b), _l = fmin_s(a, b); a = _h; b = _l; } while (0)
template <int OFF, int N> __device__ __forceinline__ void sort16(float (&v)[N]) {
    CE_DESC(v[OFF + 0], v[OFF + 1]);
    CE_DESC(v[OFF + 2], v[OFF + 3]);
    CE_DESC(v[OFF + 0], v[OFF + 2]);
    CE_DESC(v[OFF + 1], v[OFF + 3]);
    CE_DESC(v[OFF + 1], v[OFF + 2]);
    CE_DESC(v[OFF + 4], v[OFF + 5]);
    CE_DESC(v[OFF + 6], v[OFF + 7]);
    CE_DESC(v[OFF + 4], v[OFF + 6]);
    CE_DESC(v[OFF + 5], v[OFF + 7]);
    CE_DESC(v[OFF + 5], v[OFF + 6]);
    CE_DESC(v[OFF + 0], v[OFF + 4]);
    CE_DESC(v[OFF + 2], v[OFF + 6]);
    CE_DESC(v[OFF + 2], v[OFF + 4]);
    CE_DESC(v[OFF + 1], v[OFF + 5]);
    CE_DESC(v[OFF + 3], v[OFF + 7]);
    CE_DESC(v[OFF + 3], v[OFF + 5]);
    CE_DESC(v[OFF + 1], v[OFF + 2]);
    CE_DESC(v[OFF + 3], v[OFF + 4]);
    CE_DESC(v[OFF + 5], v[OFF + 6]);
    CE_DESC(v[OFF + 8], v[OFF + 9]);
    CE_DESC(v[OFF + 10], v[OFF + 11]);
    CE_DESC(v[OFF + 8], v[OFF + 10]);
    CE_DESC(v[OFF + 9], v[OFF + 11]);
    CE_DESC(v[OFF + 9], v[OFF + 10]);
    CE_DESC(v[OFF + 12], v[OFF + 13]);
    CE_DESC(v[OFF + 14], v[OFF + 15]);
    CE_DESC(v[OFF + 12], v[OFF + 14]);
    CE_DESC(v[OFF + 13], v[OFF + 15]);
    CE_DESC(v[OFF + 13], v[OFF + 14]);
    CE_DESC(v[OFF + 8], v[OFF + 12]);
    CE_DESC(v[OFF + 10], v[OFF + 14]);
    CE_DESC(v[OFF + 10], v[OFF + 12]);
    CE_DESC(v[OFF + 9], v[OFF + 13]);
    CE_DESC(v[OFF + 11], v[OFF + 15]);
    CE_DESC(v[OFF + 11], v[OFF + 13]);
    CE_DESC(v[OFF + 9], v[OFF + 10]);
    CE_DESC(v[OFF + 11], v[OFF + 12]);
    CE_DESC(v[OFF + 13], v[OFF + 14]);
    CE_DESC(v[OFF + 0], v[OFF + 8]);
    CE_DESC(v[OFF + 4], v[OFF + 12]);
    CE_DESC(v[OFF + 4], v[OFF + 8]);
    CE_DESC(v[OFF + 2], v[OFF + 10]);
    CE_DESC(v[OFF + 6], v[OFF + 14]);
    CE_DESC(v[OFF + 6], v[OFF + 10]);
    CE_DESC(v[OFF + 2], v[OFF + 4]);
    CE_DESC(v[OFF + 6], v[OFF + 8]);
    CE_DESC(v[OFF + 10], v[OFF + 12]);
    CE_DESC(v[OFF + 1], v[OFF + 9]);
    CE_DESC(v[OFF + 5], v[OFF + 13]);
    CE_DESC(v[OFF + 5], v[OFF + 9]);
    CE_DESC(v[OFF + 3], v[OFF + 11]);
    CE_DESC(v[OFF + 7], v[OFF + 15]);
    CE_DESC(v[OFF + 7], v[OFF + 11]);
    CE_DESC(v[OFF + 3], v[OFF + 5]);
    CE_DESC(v[OFF + 7], v[OFF + 9]);
    CE_DESC(v[OFF + 11], v[OFF + 13]);
    CE_DESC(v[OFF + 1], v[OFF + 2]);
    CE_DESC(v[OFF + 3], v[OFF + 4]);
    CE_DESC(v[OFF + 5], v[OFF + 6]);
    CE_DESC(v[OFF + 7], v[OFF + 8]);
    CE_DESC(v[OFF + 9], v[OFF + 10]);
    CE_DESC(v[OFF + 11], v[OFF + 12]);
    CE_DESC(v[OFF + 13], v[OFF + 14]);
}
template <int A, int B, int N> __device__ __forceinline__ void merge16(float (&v)[N]) {
#pragma unroll
    for (int i = 0; i < 16; ++i) v[A + i] = fmax_s(v[A + i], v[B + 15 - i]);
#pragma unroll
    for (int je = 3; je >= 0; --je) {
#pragma unroll
        for (int i = 0; i < 16; ++i) { const int j = 1 << je, l = i ^ j; if (l > i) CE_DESC(v[A + i], v[A + l]); }
    }
}

__device__ __forceinline__ void p0_transpose_item(const float* W, int K, int N, bf16* WT, int row_off, LAS float* scr, int item, int lane, const float* gain, bool perm_w1 = false) {
    const int nblk = N / 32, kb = item / nblk, nb = item % nblk, k0 = 64 * kb, n0 = 32 * nb;
    if (perm_w1 && n0 >= 1024) { const int np = (n0 - 1024) & 1023, q = np >> 7, i = np & 127; row_off = 1024 + 256 * q + (n0 >= 2048 ? 128 : 0) + i - n0; }
#pragma unroll 8
    for (int i = 0; i < 32; ++i) { const int kk = 2 * i + (lane >> 5); const float g = gain ? gain[k0 + kk] : 1.f; scr[kk * 33 + (lane & 31)] = W[(size_t)(k0 + kk) * N + n0 + (lane & 31)] * g; }
    LDS_WAIT(); asm volatile("" ::: "memory");
    const int c = lane & 7;
#pragma unroll
    for (int j = 0; j < 4; ++j) { const int n = (lane >> 3) + 8 * j; const LAS float* s = scr + (8 * c) * 33 + n;
        v4u o; o.x = pk2(s[0 * 33], s[1 * 33]); o.y = pk2(s[2 * 33], s[3 * 33]); o.z = pk2(s[4 * 33], s[5 * 33]); o.w = pk2(s[6 * 33], s[7 * 33]);
        *(v4u*)(WT + (size_t)(row_off + n0 + n) * K + k0 + 8 * c) = o; }
    LDS_WAIT(); asm volatile("" ::: "memory");
}
__device__ __forceinline__ void p0_fold_item(const float* __restrict__ Wq, const float* __restrict__ SKf, const float* __restrict__ gain, bf16* WT, int item, int lane) {
    item = __builtin_amdgcn_readfirstlane(item);
    const int hp = item >> 6, d = 64 * ((item >> 2) & 15) + lane, n0 = 32 * (item & 3);
    const float g = gain[d];
    f32x4 w[32];
    const f32x4* wr = (const f32x4*)(Wq + (size_t)d * QPW + hp * 128);
#pragma unroll
    for (int j = 0; j < 32; ++j) w[j] = wr[j] * g;
    const float* kb = SKf + ((size_t)hp * 128 + n0) * 128;
#pragma unroll 1
    for (int n = 0; n < 32; n += 2) {
        const f32x4* k0 = (const f32x4*)(kb + (size_t)n * 128); const f32x4* k1 = (const f32x4*)(kb + (size_t)(n + 1) * 128);
        float a0 = 0.f, a1 = 0.f, b0 = 0.f, b1 = 0.f;
#pragma unroll
        for (int j = 0; j < 32; ++j) { const f32x4 x0 = k0[j], x1 = k1[j];
            a0 = fmaf(w[j][0], x0[0], a0); a1 = fmaf(w[j][1], x0[1], a1); a0 = fmaf(w[j][2], x0[2], a0); a1 = fmaf(w[j][3], x0[3], a1);
            b0 = fmaf(w[j][0], x1[0], b0); b1 = fmaf(w[j][1], x1[1], b1); b0 = fmaf(w[j][2], x1[2], b0); b1 = fmaf(w[j][3], x1[3], b1); }
        WT[(size_t)(hp * 128 + n0 + n) * D + d] = (bf16)f2bf(a0 + a1); WT[(size_t)(hp * 128 + n0 + n + 1) * D + d] = (bf16)f2bf(b0 + b1);
    }
}
__device__ __forceinline__ float sumsq4(const f32x4 (&v)[4]) { float s = 0.f;
#pragma unroll
    for (int j = 0; j < 4; ++j) s += (v[j].x * v[j].x + v[j].y * v[j].y) + (v[j].z * v[j].z + v[j].w * v[j].w);
    return s; }
__device__ __forceinline__ float absmax4(const f32x4 (&v)[4]) { float mx = 0.f;
#pragma unroll
    for (int j = 0; j < 4; ++j) mx = fmaxf(fmaxf(mx, fmaxf(fabsf(v[j].x), fabsf(v[j].y))), fmaxf(fabsf(v[j].z), fabsf(v[j].w)));
    return mx; }
__device__ __forceinline__ void store_bf16_row(bf16* orow, const f32x4 (&v)[4], float r, int lane) {
    v2u* o8 = (v2u*)orow + lane;
#pragma unroll
    for (int j = 0; j < 4; ++j) o8[64 * j] = (v2u){pk2(v[j].x * r, v[j].y * r), pk2(v[j].z * r, v[j].w * r)};
}
__device__ __forceinline__ void norm_phase(const float* src, bf16* dst, float* RS, int gw, int NGW, int lane) {
    for (int m = gw; m < M; m += 2 * NGW) {
        const int mb = m + NGW; const bool hb = mb < M; const int mbc = hb ? mb : m;
        const f32x4* xa = (const f32x4*)(src + (size_t)m * D) + lane; const f32x4* xb = (const f32x4*)(src + (size_t)mbc * D) + lane;
        f32x4 va[4], vb[4];
#pragma unroll
        for (int j = 0; j < 4; ++j) { va[j] = xa[64 * j]; vb[j] = xb[64 * j]; }
        float sa = sumsq4(va), sb = sumsq4(vb);
#pragma unroll
        for (int o = 1; o < 64; o <<= 1) { sa += __shfl_xor(sa, o); sb += __shfl_xor(sb, o); }
        store_bf16_row(dst + (size_t)m * D, va, 1.f, lane); if (lane == 0) RS[m] = 1.f / sqrtf(sa * (1.f / D) + RMS_EPS);
        if (hb) { store_bf16_row(dst + (size_t)mb * D, vb, 1.f, lane); if (lane == 0) RS[mb] = 1.f / sqrtf(sb * (1.f / D) + RMS_EPS); }
    }
}
__device__ __forceinline__ void cvt_table(const float* src, bf16* dst, size_t n8, const float* gain  , size_t per_layer8, size_t gtid, size_t NT) {
    for (size_t i = gtid; i < n8; i += NT) {
        const f32x4 a = ((const f32x4*)src)[2 * i], b = ((const f32x4*)src)[2 * i + 1];
        f32x4 ga = (f32x4){1.f, 1.f, 1.f, 1.f}, gb = ga;
        if (gain) { const size_t layer = i / per_layer8; const int d0 = (int)((i * 8) % D); ga = *(const f32x4*)(gain + layer * D + d0); gb = *(const f32x4*)(gain + layer * D + d0 + 4); }
        v4u o; o.x = pk2(a.x * ga.x, a.y * ga.y); o.y = pk2(a.z * ga.z, a.w * ga.w); o.z = pk2(b.x * gb.x, b.y * gb.y); o.w = pk2(b.z * gb.z, b.w * gb.w);
        ((v4u*)dst)[i] = o;
    }
}

__device__ __forceinline__ void conv_phase(const bf16* Bb, const bf16* Ub, const float* ck, bf16* Y, int gw, int NGW, int lane) {
    for (int item = gw; item < (M / 16) * 2; item += NGW) {
        const int run = item >> 1, hr = item & 1, t0 = run * 16, d0 = hr * 512 + lane * 8;
        float k0[8], k1[8], k2[8];
#pragma unroll
        for (int q = 0; q < 2; ++q) { const f32x4 a = *(const f32x4*)(ck + d0 + 4 * q), b = *(const f32x4*)(ck + D + d0 + 4 * q), c = *(const f32x4*)(ck + 2 * D + d0 + 4 * q);
#pragma unroll
            for (int e = 0; e < 4; ++e) { k0[4 * q + e] = a[e]; k1[4 * q + e] = b[e]; k2[4 * q + e] = c[e]; } }
        float up2[8], up1[8];
#pragma unroll
        for (int e = 0; e < 8; ++e) { up2[e] = 0.f; up1[e] = 0.f; }
        if ((t0 & (SEQ - 1)) != 0) { const v4u a = *(const v4u*)(Ub + (size_t)(t0 - 2) * D + d0), b = *(const v4u*)(Ub + (size_t)(t0 - 1) * D + d0);
#pragma unroll
            for (int e = 0; e < 4; ++e) { up2[2 * e] = bflo(a[e]); up2[2 * e + 1] = bfhi(a[e]); up1[2 * e] = bflo(b[e]); up1[2 * e + 1] = bfhi(b[e]); } }
#pragma unroll 4
        for (int tt = 0; tt < 16; ++tt) { const v4u b = *(const v4u*)(Bb + (size_t)(t0 + tt) * D + d0), uu = *(const v4u*)(Ub + (size_t)(t0 + tt) * D + d0);
            float u[8], y[8];
#pragma unroll
            for (int e = 0; e < 4; ++e) { u[2 * e] = bflo(uu[e]); u[2 * e + 1] = bfhi(uu[e]); }
#pragma unroll
            for (int e = 0; e < 8; ++e) y[e] = k0[e] * up2[e] + k1[e] * up1[e] + k2[e] * u[e];
            v4u o;
#pragma unroll
            for (int e = 0; e < 4; ++e) o[e] = pk2(bflo(b[e]) * y[2 * e], bfhi(b[e]) * y[2 * e + 1]);
            *(v4u*)(Y + (size_t)(t0 + tt) * D + d0) = o;
#pragma unroll
            for (int e = 0; e < 8; ++e) { up2[e] = up1[e]; up1[e] = u[e]; } }
    }
}

__device__ __forceinline__ float enc_low(float s, unsigned keep_mask, unsigned code) { return __uint_as_float((__float_as_uint(s) & keep_mask) | code); }
__device__ __forceinline__ void sel_load_s(const _Float16* SP, int t0, int h, int p, int r32, int hi, v4u (&sf)[8]) {
    const char* sbase = (const char*)(SP + (size_t)t0 * QPW + h * 256 + p * 128);
    unsigned soff = (unsigned)(r32 * QPW + hi * 64) * 2u; asm volatile("" : "+v"(soff));
#pragma unroll
    for (int c = 0; c < 8; ++c) sf[c] = *(const v4u*)(sbase + (soff + c * 16u));
}
__device__ __forceinline__ void sel_decode(const v4u (&sf)[8], float (&v)[64]) {
    typedef _Float16 h2d __attribute__((ext_vector_type(2)));
#pragma unroll
    for (int i = 0; i < 64; i += 2) { const unsigned wd = sf[i >> 3][(i >> 1) & 3]; const h2d t = __builtin_bit_cast(h2d, wd);
        v[i] = enc_low((float)t.x, 0xFFFFFF80u, (unsigned)(63 - i)); v[i + 1] = enc_low((float)t.y, 0xFFFFFF80u, (unsigned)(62 - i)); }
}
__device__ __forceinline__ void sel_top16(float (&v)[64], unsigned hbit  ) {
    sort16<0>(v); sort16<16>(v); sort16<32>(v); sort16<48>(v);
    merge16<0, 16>(v); merge16<32, 48>(v); merge16<0, 32>(v);
#pragma unroll
    for (int i = 0; i < 16; ++i) { const unsigned x = __float_as_uint(v[i]) | hbit; auto rr = __builtin_amdgcn_permlane32_swap(x, x, false, false); v[i] = __uint_as_float(rr[0]); v[16 + i] = __uint_as_float(rr[1]); }
    merge16<0, 16>(v);
}
typedef _Float16 h2v __attribute__((ext_vector_type(2)));
__device__ __forceinline__ unsigned pkh2(float a, float b) { const h2v t = (h2v){(_Float16)a, (_Float16)b}; return __builtin_bit_cast(unsigned, t); }
__device__ __forceinline__ void sel_finish(const float (&A)[16], const float (&B)[16], int t0, int h, int r32, int hi, unsigned short* IDX, _Float16* GATE) {
    float list[64]; int n = 0;
#pragma unroll
    for (int a = 0; a < 16; ++a)
#pragma unroll
        for (int b = 0; b < 16; ++b) if ((a + 1) * (b + 1) <= 16) { list[n] = enc_low(A[a] + B[b], 0xFFFFFF00u, (unsigned)(a * 16 + b)); ++n; }
#pragma unroll
    for (int i = 50; i < 64; ++i) list[i] = -INFINITY;
    float cv[32];
#pragma unroll
    for (int i = 0; i < 32; ++i) { const float c1 = opq(list[32 + i]), c0 = opq(list[i]); cv[i] = hi ? c1 : c0; }
    sort16<0>(cv); sort16<16>(cv); merge16<0, 16>(cv);
#pragma unroll
    for (int i = 0; i < 16; ++i) { const unsigned x = __float_as_uint(cv[i]); auto rr = __builtin_amdgcn_permlane32_swap(x, x, false, false); cv[i] = __uint_as_float(rr[0]); cv[16 + i] = __uint_as_float(rr[1]); }
    merge16<0, 16>(cv);
    unsigned pA[4], pB[4];
#pragma unroll
    for (int d = 0; d < 4; ++d) { pA[d] = 0u; pB[d] = 0u;
#pragma unroll
        for (int j = 0; j < 4; ++j) { pA[d] |= (127u - (__float_as_uint(A[4 * d + j]) & 127u)) << (8 * j); pB[d] |= (127u - (__float_as_uint(B[4 * d + j]) & 127u)) << (8 * j); } }
    int eid[16]; float gt[16]; float gsum = 0.f;
    const unsigned qa0 = (unsigned)opq((int)pA[0]), qa1 = (unsigned)opq((int)pA[1]), qa2 = (unsigned)opq((int)pA[2]), qa3 = (unsigned)opq((int)pA[3]);
    const unsigned qb0 = (unsigned)opq((int)pB[0]), qb1 = (unsigned)opq((int)pB[1]), qb2 = (unsigned)opq((int)pB[2]), qb3 = (unsigned)opq((int)pB[3]);
#pragma unroll
    for (int k = 0; k < 16; ++k) { const unsigned code = __float_as_uint(cv[k]) & 255u, a = code >> 4, b = code & 15u;
        const unsigned sa = (a & 7u) | 0x0c0c0c00u, sb = (b & 7u) | 0x0c0c0c00u;
        const unsigned a_lo = __builtin_amdgcn_perm(qa1, qa0, sa), a_hi = __builtin_amdgcn_perm(qa3, qa2, sa), b_lo = __builtin_amdgcn_perm(qb1, qb0, sb), b_hi = __builtin_amdgcn_perm(qb3, qb2, sb);
        const unsigned n1 = (a & 8u) ? a_hi : a_lo, n2 = (b & 8u) ? b_hi : b_lo;
        eid[k] = (int)(n1 * 128u + n2); gt[k] = __expf(cv[k] - cv[0]); gsum += gt[k]; }
    const float ginv = 1.f / gsum;
    unsigned short e8[8]; float g8[8];
#pragma unroll
    for (int i = 0; i < 8; ++i) { const int e1 = opq(eid[8 + i]), e0 = opq(eid[i]); const float g1 = opq(gt[8 + i]), g0 = opq(gt[i]); e8[i] = (unsigned short)(hi ? e1 : e0); g8[i] = (hi ? g1 : g0) * ginv; }
    v4u pe; pe.x = e8[0] | ((unsigned)e8[1] << 16); pe.y = e8[2] | ((unsigned)e8[3] << 16); pe.z = e8[4] | ((unsigned)e8[5] << 16); pe.w = e8[6] | ((unsigned)e8[7] << 16);
    const size_t sbase = (size_t)t0 * 128 + h * 16; const unsigned soff = (unsigned)(r32 * 128 + 8 * hi);
    *(v4u*)((char*)(IDX + sbase) + soff * 2u) = pe;
    *(v4u*)((char*)(GATE + sbase) + soff * 2u) = (v4u){pkh2(g8[0], g8[1]), pkh2(g8[2], g8[3]), pkh2(g8[4], g8[5]), pkh2(g8[6], g8[7])};
}

typedef float f32x2 __attribute__((ext_vector_type(2)));
__device__ __forceinline__ float wave_max(float v) {
#pragma unroll
    for (int o = 1; o < 64; o <<= 1) v = fmaxf(v, __shfl_xor(v, o));
    return v;
}
__device__ __forceinline__ int row16_sum_i(int s) {
    s += __builtin_amdgcn_update_dpp(0, s, 0xB1, 0xF, 0xF, true);
    s += __builtin_amdgcn_update_dpp(0, s, 0x4E, 0xF, 0xF, true);
    s += __builtin_amdgcn_update_dpp(0, s, 0x141, 0xF, 0xF, true);
    s += __builtin_amdgcn_update_dpp(0, s, 0x140, 0xF, 0xF, true);
    return s;
}
__device__ __forceinline__ unsigned pack_i8x4(f32x4 v, float inv) {
    const int a = (int)rintf(v.x * inv), b = (int)rintf(v.y * inv), c = (int)rintf(v.z * inv), d = (int)rintf(v.w * inv);
    return ((unsigned)a & 255u) | (((unsigned)b & 255u) << 8) | (((unsigned)c & 255u) << 16) | (((unsigned)d & 255u) << 24);
}
__device__ __forceinline__ void quant_u_phase(const float* U, const float* gain, unsigned char* Uq, float* su, int gw, int NGW, int lane) {
    for (int row = gw; row < 2 * NEXP; row += NGW) {
        const int layer = row / NEXP;
        const f32x4* ur = (const f32x4*)(U + (size_t)row * D) + 2 * lane; const f32x4* gr = (const f32x4*)(gain + (size_t)layer * D) + 2 * lane;
        f32x4 v[2][2]; float mx = 0.f, ss = 0.f;
#pragma unroll
        for (int j = 0; j < 2; ++j)
#pragma unroll
            for (int h = 0; h < 2; ++h) { v[j][h] = ur[128 * j + h] * gr[128 * j + h]; const f32x4 t = v[j][h];
                mx = fmaxf(fmaxf(mx, fmaxf(fabsf(t.x), fabsf(t.y))), fmaxf(fabsf(t.z), fabsf(t.w))); ss += (t.x * t.x + t.y * t.y) + (t.z * t.z + t.w * t.w); }
        mx = wave_max(mx); ss = wave_sum(ss);
        const float clip = fminf(mx, 2.5f * sqrtf(ss * (1.f / D))); const float sc = clip > 0.f ? clip * (1.f / 7.f) : 1.f, inv = 1.f / sc;
        unsigned* qr = (unsigned*)(Uq + (size_t)row * (D / 2)) + lane;
#pragma unroll
        for (int j = 0; j < 2; ++j) { unsigned w = 0;
#pragma unroll
            for (int e = 0; e < 4; ++e) { const int lo = (int)fminf(fmaxf(rintf(v[j][0][e] * inv), -7.f), 7.f), hi = (int)fminf(fmaxf(rintf(v[j][1][e] * inv), -7.f), 7.f);
                w |= (((unsigned)lo & 15u) | (((unsigned)hi & 15u) << 4)) << (8 * e); }
            qr[64 * j] = w; }
        if (lane == 0) su[row] = sc;
    }
}
__device__ __forceinline__ void quant_v_phase(const float* V, unsigned char* Vq, float* sv, int gw, int NGW, int lane) {
    for (int row = gw; row < 2 * NEXP; row += NGW) {
        const int layer = row / NEXP, e = row % NEXP;
        const f32x4* vr = (const f32x4*)(V + (size_t)row * D) + 4 * lane;
        f32x4 v[4]; float mx = 0.f;
#pragma unroll
        for (int q = 0; q < 4; ++q) { v[q] = vr[q]; mx = fmaxf(fmaxf(mx, fmaxf(fabsf(v[q].x), fabsf(v[q].y))), fmaxf(fabsf(v[q].z), fabsf(v[q].w))); }
        mx = wave_max(mx); const float sc = mx > 0.f ? mx * (1.f / 6.f) : 1.f, inv = 1.f / sc;
        v2u o;
#pragma unroll
        for (int d = 0; d < 2; ++d) { unsigned p = 0u;
            p = __builtin_amdgcn_cvt_scalef32_pk_fp4_f32(p, v[2 * d].x * inv, v[2 * d].y * inv, 1.0f, 0); p = __builtin_amdgcn_cvt_scalef32_pk_fp4_f32(p, v[2 * d].z * inv, v[2 * d].w * inv, 1.0f, 1);
            p = __builtin_amdgcn_cvt_scalef32_pk_fp4_f32(p, v[2 * d + 1].x * inv, v[2 * d + 1].y * inv, 1.0f, 2); p = __builtin_amdgcn_cvt_scalef32_pk_fp4_f32(p, v[2 * d + 1].z * inv, v[2 * d + 1].w * inv, 1.0f, 3);
            o[d] = p; }
        *(v2u*)(Vq + (((size_t)layer * 4 + (lane >> 4)) * NEXP + e) * 128 + (lane & 15) * 8) = o;
        if (lane == 0) sv[row] = sc;
    }
}
__device__ __forceinline__ f32x4 bf4_to_f32(v2u w) { return (f32x4){bflo(w.x), bfhi(w.x), bflo(w.y), bfhi(w.y)}; }
__device__ __forceinline__ void norm_q_store(f32x4 (&v)[4], float ss, float mx, float* rsp, signed char* qrow, float* sxp, int lane) {
    const float r = 1.f / sqrtf(ss * (1.f / D) + RMS_EPS); mx = fminf(mx * r, 2.5f); const float sh = mx > 0.f ? mx * (1.f / 7.f) : 1.f, ih = r / sh;
    const int sft = (lane & 1) ? 4 : 0;
#pragma unroll
    for (int j = 0; j < 4; ++j) { unsigned ph = 0u;
#pragma unroll
        for (int e = 0; e < 4; ++e) { const float qh = fminf(fmaxf(rintf(v[j][e] * ih), -7.f), 7.f); ph |= ((unsigned)(int)qh & 15u) << (8 * e + sft); }
        ph |= (unsigned)__builtin_amdgcn_update_dpp(0, (int)ph, 0xB1, 0xF, 0xF, true);
        if (!(lane & 1)) ((unsigned*)qrow)[(lane >> 1) + 32 * j] = ph; }
    if (lane == 0) { *sxp = sh; *rsp = r; }
}
__device__ __forceinline__ void norm_q_phase(const bf16* src, float* RS, signed char* Xq, float* sx, int gw, int NGW, int lane) {
    for (int m = gw; m < M; m += 2 * NGW) {
        const int mb = m + NGW; const bool hb = mb < M; const int mbc = hb ? mb : m;
        const v2u* xa = (const v2u*)(src + (size_t)m * D) + lane; const v2u* xb = (const v2u*)(src + (size_t)mbc * D) + lane;
        v2u ra[4], rb[4];
#pragma unroll
        for (int j = 0; j < 4; ++j) { ra[j] = xa[64 * j]; rb[j] = xb[64 * j]; }
        f32x4 va[4], vb[4];
#pragma unroll
        for (int j = 0; j < 4; ++j) { va[j] = bf4_to_f32(ra[j]); vb[j] = bf4_to_f32(rb[j]); }
        float sa = sumsq4(va), sb = sumsq4(vb), ma = absmax4(va), mbx = absmax4(vb);
#pragma unroll
        for (int o = 1; o < 64; o <<= 1) { sa += __shfl_xor(sa, o); sb += __shfl_xor(sb, o); ma = fmaxf(ma, __shfl_xor(ma, o)); mbx = fmaxf(mbx, __shfl_xor(mbx, o)); }
        norm_q_store(va, sa, ma, RS + m, Xq + (size_t)m * (D / 2), sx + m, lane);
        if (hb) norm_q_store(vb, sb, mbx, RS + mb, Xq + (size_t)mb * (D / 2), sx + mb, lane);
    }
}
__device__ __forceinline__ void select_phase(const _Float16* SP, unsigned short* IDX, _Float16* GATE, int bx, int G, int wave, int lane) {
    const int h = bx & 7, rank = bx >> 3, nr = (G - h + 7) >> 3;
    const int r32 = lane & 31, hi = lane >> 5;
    const unsigned hbit = hi ? 0u : 64u;
    const int stride = nr * NWAVES; int tile = rank * NWAVES + wave;
    v4u sA[8], sB[8];
    if (tile < M / 32) sel_load_s(SP, tile * 32, h, 0, r32, hi, sA);
    for (; tile < M / 32; tile += stride) {
        const int t0 = tile * 32;
        float v[64], A[16], B[16];
        sel_decode(sA, v);
        sel_load_s(SP, t0, h, 1, r32, hi, sB);
        sel_top16(v, hbit);
#pragma unroll
        for (int i = 0; i < 16; ++i) A[i] = v[i];
        sel_decode(sB, v);
        if (tile + stride < M / 32) sel_load_s(SP, (tile + stride) * 32, h, 0, r32, hi, sA);
        sel_top16(v, hbit);
#pragma unroll
        for (int i = 0; i < 16; ++i) B[i] = v[i];
        sel_finish(A, B, t0, h, r32, hi, IDX, GATE);
    }
}
__device__ __forceinline__ f32x2 gelu2(f32x2 v) {
    const f32x2 av = __builtin_elementwise_abs(v), d = av * 0.2316418882f + 1.0f;
    f32x2 t; t.x = __builtin_amdgcn_rcpf(d.x); t.y = __builtin_amdgcn_rcpf(d.y);
    f32x2 q = t * 0.5307027145f + (-0.7265760135f); q = q * t + 0.7107068705f; q = q * t + (-0.142248368f); q = q * t + 0.127414796f; q = q * t;
    const f32x2 s = (v * v) * (-0.72134752044f);
    f32x2 e; e.x = __builtin_amdgcn_exp2f(s.x); e.y = __builtin_amdgcn_exp2f(s.y);
    const f32x2 m = v * (q * e), r = v - m;
    f32x2 o; o.x = v.x < 0.f ? m.x : r.x; o.y = v.y < 0.f ? m.y : r.y; return o;
}
constexpr int UB = 8, USTEPS = 12;
struct UStep { v4u w[4]; unsigned k; bool v; };
__device__ __forceinline__ void u_issue_step(const unsigned char* Uql, const LAS unsigned* list, int n, int it, int rg, int c8, unsigned emask, UStep& S) {
    const int ent = it * 8 + rg; S.v = ent < n; const unsigned entry = list[S.v ? ent : 0]; S.k = entry >> 16;
    const unsigned char* up = Uql + ((entry & emask) * (unsigned)(D / 2) + 16u * c8);
#pragma unroll
    for (int j = 0; j < 4; ++j) S.w[j] = *(const v4u*)(up + 128 * j);
}
__device__ __forceinline__ void u_compute_step(const UStep& S, const v4u (&xq)[4], LAS float* actl, LAS float* dummy) {
    int a0 = 0, a1 = 0;
#pragma unroll
    for (int j = 0; j < 4; j += 2)
#pragma unroll
        for (int q = 0; q < 4; ++q) { a0 = __builtin_amdgcn_sdot8((int)S.w[j][q], (int)xq[j][q], a0, false); a1 = __builtin_amdgcn_sdot8((int)S.w[j + 1][q], (int)xq[j + 1][q], a1, false); }
    int acc = a0 + a1;
    acc += __builtin_amdgcn_update_dpp(0, acc, 0xB1, 0xF, 0xF, true); acc += __builtin_amdgcn_update_dpp(0, acc, 0x4E, 0xF, 0xF, true); acc += __builtin_amdgcn_update_dpp(0, acc, 0x141, 0xF, 0xF, true);
    LAS float* dst = S.v ? actl + S.k : dummy; *dst = (float)acc;
}
struct UTok { int n; unsigned ea, eb; bool ma, mb; float sua, sva, sub, svb; };
__device__ __forceinline__ void u_prep(const LAS unsigned char* slot, int x, int lane, LAS unsigned* list, const float* sul, const float* svl, bool tv, UTok& T) {
    T.ea = ((const LAS unsigned short*)(slot + 1024))[lane]; T.eb = ((const LAS unsigned short*)(slot + 1024))[64 + lane];
    T.ma = tv && (int)(T.ea >> 12) == x; T.mb = tv && (int)(T.eb >> 12) == x;
    const unsigned long long ba = __ballot(T.ma), bb = __ballot(T.mb);
    const unsigned pa = __builtin_amdgcn_mbcnt_hi((unsigned)(ba >> 32), __builtin_amdgcn_mbcnt_lo((unsigned)ba, 0u)), ca = (unsigned)__popcll(ba);
    const unsigned pb = ca + __builtin_amdgcn_mbcnt_hi((unsigned)(bb >> 32), __builtin_amdgcn_mbcnt_lo((unsigned)bb, 0u));
    if (T.ma) list[pa] = ((unsigned)lane << 16) | T.ea;
    if (T.mb) list[pb] = ((unsigned)(64 + lane) << 16) | T.eb;
    T.n = (int)(ca + (unsigned)__popcll(bb));
    T.sua = 0.f; T.sva = 0.f; T.sub = 0.f; T.svb = 0.f;
    if (T.ma) { T.sua = sul[T.ea]; T.sva = svl[T.ea]; }
    if (T.mb) { T.sub = sul[T.eb]; T.svb = svl[T.eb]; }
}
__device__ __forceinline__ void u_finish(const UTok& T, const LAS unsigned char* slot, float sxt, const LAS float* actl, _Float16* crow, int lane) {
    const LAS _Float16* gl = (const LAS _Float16*)(slot + 1280);
    const f32x2 g = gelu2((f32x2){actl[lane] * T.sua * sxt, actl[64 + lane] * T.sub * sxt});
    if (T.ma) crow[lane] = (_Float16)((float)gl[lane] * g.x * T.sva);
    if (T.mb) crow[64 + lane] = (_Float16)((float)gl[64 + lane] * g.y * T.svb);
}
constexpr int USET = 5;
__device__ __forceinline__ void peer_u_phase(const signed char* Xq, const float* sx, const unsigned short* IDX, const _Float16* GATE, const unsigned char* Uql, const float* sul, const float* svl, _Float16* COEF,
                                             int bx, int G, int wave, int lane, LAS unsigned char* lds, unsigned emask = 0x3fffu) {
    const int x = (bx & 7) >> 1, rank = (bx >> 3) * 2 + (bx & 1), nr = 2 * ((G - (bx & 6) + 7) >> 3);
    const int c8 = lane & 7, rg = lane >> 3;
    LAS unsigned char* wl = lds + wave * 16384;
    LAS unsigned* listA = (LAS unsigned*)(wl + 14336); LAS unsigned* listB = (LAS unsigned*)(wl + 14336 + 512);
    LAS float* actA = (LAS float*)(wl + 14336 + 1024); LAS float* actB = (LAS float*)(wl + 14336 + 1536);
    LAS float* sxl = (LAS float*)(lds + 132096 + wave * 64);
    LAS float* dummy = sxl + 8 + rg;
    const int stride = nr * NWAVES, tfirst = rank * NWAVES + wave, NI = (tfirst < M) ? (M - tfirst + stride - 1) / stride : 0;
    for (int i0 = 0; i0 < NI; i0 += UB) {
        { v4u xr[UB / 2], ir[2], gr[2]; float sxv = 0.f;
#pragma unroll
          for (int h = 0; h < UB / 2; ++h) { const int jj = 2 * h + (lane >> 5); const int tj = tfirst + (i0 + jj < NI ? i0 + jj : NI - 1) * stride; xr[h] = *(const v4u*)(Xq + (size_t)tj * (D / 2) + 16 * (lane & 31)); }
#pragma unroll
          for (int h = 0; h < 2; ++h) { const int jj = 4 * h + (lane >> 4); const int tj = tfirst + (i0 + jj < NI ? i0 + jj : NI - 1) * stride; ir[h] = *(const v4u*)(IDX + (size_t)tj * 128 + 8 * (lane & 15)); }
#pragma unroll
          for (int h = 0; h < 2; ++h) { const int jj = 4 * h + (lane >> 4); const int tj = tfirst + (i0 + jj < NI ? i0 + jj : NI - 1) * stride; gr[h] = *(const v4u*)(GATE + (size_t)tj * 128 + 8 * (lane & 15)); }
          if (lane < UB) { const int tj = tfirst + (i0 + lane < NI ? i0 + lane : NI - 1) * stride; sxv = sx[tj]; }
#pragma unroll
          for (int h = 0; h < UB / 2; ++h) *(LAS v4u*)(wl + 1792 * (2 * h + (lane >> 5)) + 16 * (lane & 31)) = xr[h];
#pragma unroll
          for (int h = 0; h < 2; ++h) *(LAS v4u*)(wl + 1792 * (4 * h + (lane >> 4)) + 1024 + 16 * (lane & 15)) = ir[h];
#pragma unroll
          for (int h = 0; h < 2; ++h) *(LAS v4u*)(wl + 1792 * (4 * h + (lane >> 4)) + 1280 + 16 * (lane & 15)) = gr[h];
          if (lane < UB) sxl[lane] = sxv; }
#pragma unroll 1
        for (int j = 0; j < UB && i0 + j < NI; j += 2) {
            const bool tvB = (j + 1 < UB) && (i0 + j + 1 < NI);
            const LAS unsigned char* slotA = wl + 1792 * j; const LAS unsigned char* slotB = wl + 1792 * (tvB ? j + 1 : j);
            UTok TA, TB;
            u_prep(slotA, x, lane, listA, sul, svl, true, TA);
            u_prep(slotB, x, lane, listB, sul, svl, tvB, TB);
            UStep SA[USET], SB[USET];
#pragma unroll
            for (int u = 0; u < USET; ++u) u_issue_step(Uql, listA, TA.n, u, rg, c8, emask, SA[u]);
#pragma unroll
            for (int u = 0; u < USET; ++u) u_issue_step(Uql, listB, TB.n, u, rg, c8, emask, SB[u]);
            v4u xq[4];
#pragma unroll
            for (int h = 0; h < 4; ++h) xq[h] = *(const LAS v4u*)(slotA + 16 * c8 + 128 * h);
#pragma unroll
            for (int u = 0; u < USET; ++u) u_compute_step(SA[u], xq, actA, dummy);
            for (int it = USET; it * 8 < TA.n; ++it) { UStep t_; u_issue_step(Uql, listA, TA.n, it, rg, c8, emask, t_); u_compute_step(t_, xq, actA, dummy); }
#pragma unroll
            for (int h = 0; h < 4; ++h) xq[h] = *(const LAS v4u*)(slotB + 16 * c8 + 128 * h);
#pragma unroll
            for (int u = 0; u < USET; ++u) u_compute_step(SB[u], xq, actB, dummy);
            for (int it = USET; it * 8 < TB.n; ++it) { UStep t_; u_issue_step(Uql, listB, TB.n, it, rg, c8, emask, t_); u_compute_step(t_, xq, actB, dummy); }
            u_finish(TA, slotA, sxl[j], actA, COEF + (size_t)(tfirst + (i0 + j) * stride) * 128, lane);
            if (tvB) u_finish(TB, slotB, sxl[j + 1], actB, COEF + (size_t)(tfirst + (i0 + j + 1) * stride) * 128, lane);
        }
    }
}
constexpr int VB = 16;
__device__ __forceinline__ void v_issue(const unsigned char* Vs, const LAS unsigned char* slot, unsigned grp, unsigned c8off, v4u (&w)[16]) {
    v4u ev[2];
#pragma unroll
    for (int q = 0; q < 2; ++q) ev[q] = *(const LAS v4u*)(slot + 256 + 32 * grp + 16 * q);
#pragma unroll
    for (int i = 0; i < 16; ++i) { const unsigned pr = ev[i >> 3][(i >> 1) & 3], e = (i & 1) ? (pr >> 16) : (pr & 0xffffu); w[i] = *(const v4u*)(Vs + (e * 128u + c8off)); }
}
__device__ __forceinline__ void v_compute_store(const LAS unsigned char* slot, unsigned grp, const v4u (&w)[16], v2u* op, float* sp, bool o8, int lane) {
    const v2u hres = *op;
    v4u cw[2];
#pragma unroll
    for (int q = 0; q < 2; ++q) cw[q] = *(const LAS v4u*)(slot + 32 * grp + 16 * q);
    typedef _Float16 h2 __attribute__((ext_vector_type(2)));
    h2 ah[16];
#pragma unroll
    for (int i = 0; i < 16; ++i) ah[i] = (h2){(_Float16)0.f, (_Float16)0.f};
#pragma unroll
    for (int i = 0; i < 16; ++i) { const unsigned cpr = cw[i >> 3][(i >> 1) & 3]; const h2 cp = __builtin_bit_cast(h2, cpr); const _Float16 ch = (i & 1) ? cp.y : cp.x; const h2 c = (h2){ch, ch};
#pragma unroll
        for (int q = 0; q < 4; ++q) { const unsigned wv = w[i][q];
            ah[4 * q + 0] += __builtin_amdgcn_cvt_scalef32_pk_f16_fp4(wv, 1.0f, 0) * c; ah[4 * q + 1] += __builtin_amdgcn_cvt_scalef32_pk_f16_fp4(wv, 1.0f, 1) * c;
            ah[4 * q + 2] += __builtin_amdgcn_cvt_scalef32_pk_f16_fp4(wv, 1.0f, 2) * c; ah[4 * q + 3] += __builtin_amdgcn_cvt_scalef32_pk_f16_fp4(wv, 1.0f, 3) * c; } }
    h2 kA[8], kB[4];
#pragma unroll
    for (int f = 0; f < 8; ++f) { auto rr = __builtin_amdgcn_permlane32_swap(__builtin_bit_cast(unsigned, ah[f]), __builtin_bit_cast(unsigned, ah[8 + f]), false, false); kA[f] = __builtin_bit_cast(h2, (unsigned)rr[0]) + __builtin_bit_cast(h2, (unsigned)rr[1]); }
#pragma unroll
    for (int f = 0; f < 4; ++f) { auto rr = __builtin_amdgcn_permlane16_swap(__builtin_bit_cast(unsigned, kA[f]), __builtin_bit_cast(unsigned, kA[4 + f]), false, false); kB[f] = __builtin_bit_cast(h2, (unsigned)rr[0]) + __builtin_bit_cast(h2, (unsigned)rr[1]); }
    float kC[4];
#pragma unroll
    for (int f = 0; f < 2; ++f) { const h2 own = o8 ? kB[2 + f] : kB[f];
        const h2 oth = o8 ? kB[f] : kB[2 + f];
        const h2 got = __builtin_bit_cast(h2, (unsigned)__builtin_amdgcn_update_dpp(0, (int)__builtin_bit_cast(unsigned, oth), 0x128, 0xF, 0xF, true));
        const h2 t = own + got; kC[2 * f] = (float)t.x; kC[2 * f + 1] = (float)t.y; }
    const float o0 = kC[0] + bflo(hres.x), o1 = kC[1] + bfhi(hres.x), o2 = kC[2] + bflo(hres.y), o3 = kC[3] + bfhi(hres.y);
    *op = (v2u){pk2(o0, o1), pk2(o2, o3)};
    float ss = (o0 * o0 + o1 * o1) + (o2 * o2 + o3 * o3);
    ss += __builtin_amdgcn_update_dpp(0.f, ss, 0xB1, 0xF, 0xF, true); ss += __builtin_amdgcn_update_dpp(0.f, ss, 0x4E, 0xF, 0xF, true);
    ss += __builtin_amdgcn_update_dpp(0.f, ss, 0x124, 0xF, 0xF, true); ss += __builtin_amdgcn_update_dpp(0.f, ss, 0x128, 0xF, 0xF, true);
    ss += __builtin_amdgcn_update_dpp(0.f, ss, 0x142, 0xA, 0xF, false); ss += __builtin_amdgcn_update_dpp(0.f, ss, 0x143, 0xC, 0xF, false);
    if (lane == 63) *sp = ss;
}
__device__ __forceinline__ void peer_v_phase(const _Float16* COEF, const unsigned short* IDX, const unsigned char* Vql, bf16* Hres, float* SSQ4, int bx, int G, int wave, int lane, LAS unsigned char* lds) {
    const int s = (bx & 7) >> 1, rank = (bx >> 3) * 2 + (bx & 1), nr = 2 * ((G - (bx & 6) + 7) >> 3);
    const unsigned char* Vs = Vql + (size_t)s * NEXP * 128;
    LAS unsigned char* wl = lds + wave * 12288;
    const LAS unsigned char* zslot = wl + 512 * VB;
    *(LAS v2u*)(wl + 512 * VB + 8 * lane) = (v2u){0u, 0u};
    const unsigned grp = (unsigned)(lane >> 3), c8off = (unsigned)(lane & 7) * 16u;
    const bool hi = (lane & 32) != 0, odd = (lane & 16) != 0, o8 = (lane & 8) != 0;
    bf16* Ocol = Hres + s * 256 + 32 * (lane & 7) + (hi ? 16 : 0) + (odd ? 8 : 0) + (o8 ? 4 : 0);
    const int stride = nr * NWAVES, tfirst = rank * NWAVES + wave, NI = (tfirst < M) ? (M - tfirst + stride - 1) / stride : 0;
    for (int i0 = 0; i0 < NI; i0 += VB) {
        { v4u cr[VB / 4], ir[VB / 4];
#pragma unroll
          for (int h = 0; h < VB / 4; ++h) { const int jj = 4 * h + (lane >> 4); const int tj = tfirst + (i0 + jj < NI ? i0 + jj : NI - 1) * stride; cr[h] = *(const v4u*)(COEF + (size_t)tj * 128 + 8 * (lane & 15)); }
#pragma unroll
          for (int h = 0; h < VB / 4; ++h) { const int jj = 4 * h + (lane >> 4); const int tj = tfirst + (i0 + jj < NI ? i0 + jj : NI - 1) * stride; ir[h] = *(const v4u*)(IDX + (size_t)tj * 128 + 8 * (lane & 15)); }
#pragma unroll
          for (int h = 0; h < VB / 4; ++h) *(LAS v4u*)(wl + 512 * (4 * h + (lane >> 4)) + 16 * (lane & 15)) = cr[h];
#pragma unroll
          for (int h = 0; h < VB / 4; ++h) *(LAS v4u*)(wl + 512 * (4 * h + (lane >> 4)) + 256 + 16 * (lane & 15)) = ir[h]; }
        const int nb = (NI - i0 < VB) ? (NI - i0) : VB;
        v4u wA[16], wB[16];
        v_issue(Vs, wl, grp, c8off, wA);
#pragma unroll 1
        for (int j = 0; j < nb; j += 2) {
            v_issue(Vs, (j + 1 < nb) ? wl + 512 * (j + 1) : zslot, grp, c8off, wB);
            { const int tt = tfirst + (i0 + j) * stride; v_compute_store(wl + 512 * j, grp, wA, (v2u*)(Ocol + (size_t)tt * D), SSQ4 + 4 * (size_t)tt + s, o8, lane); }
            if (j + 1 >= nb) break;
            v_issue(Vs, (j + 2 < nb) ? wl + 512 * (j + 2) : zslot, grp, c8off, wA);
            { const int tt = tfirst + (i0 + j + 1) * stride; v_compute_store(wl + 512 * (j + 1), grp, wB, (v2u*)(Ocol + (size_t)tt * D), SSQ4 + 4 * (size_t)tt + s, o8, lane); }
        }
    }
}
__device__ __forceinline__ void final_norm_phase(const bf16* Hb, const float* SSQ4, const float* gfin, float* out, int gw, int NGW, int lane) {
    const f32x4* gr = (const f32x4*)gfin + lane;
    for (int m = gw; m < M; m += 2 * NGW) {
        const int mb = m + NGW; const bool hb = mb < M; const int mbc = hb ? mb : m;
        const v2u* xa = (const v2u*)(Hb + (size_t)m * D) + lane; const v2u* xb = (const v2u*)(Hb + (size_t)mbc * D) + lane;
        v2u ra[4], rb[4];
#pragma unroll
        for (int j = 0; j < 4; ++j) { ra[j] = xa[64 * j]; rb[j] = xb[64 * j]; }
        const f32x4 qa = *(const f32x4*)(SSQ4 + 4 * (size_t)m), qb = *(const f32x4*)(SSQ4 + 4 * (size_t)mbc);
        const float rA = 1.f / sqrtf(((qa[0] + qa[1]) + (qa[2] + qa[3])) * (1.f / D) + RMS_EPS), rB = 1.f / sqrtf(((qb[0] + qb[1]) + (qb[2] + qb[3])) * (1.f / D) + RMS_EPS);
        f32x4* oa = (f32x4*)(out + (size_t)m * D) + lane; f32x4* ob = (f32x4*)(out + (size_t)mbc * D) + lane;
#pragma unroll
        for (int j = 0; j < 4; ++j) { const f32x4 g = gr[64 * j]; oa[64 * j] = bf4_to_f32(ra[j]) * rA * g; if (hb) ob[64 * j] = bf4_to_f32(rb[j]) * rB * g; }
    }
}

template <bool DIAG> __device__ __forceinline__ void attn_tile(const f32x16& s, int qrel  , int hi, float& carry  , v4u (&pa)[2]) {
    float R[16], Bt[16];
#pragma unroll
    for (int r = 0; r < 16; ++r) { const float t = __builtin_amdgcn_exp2f(fminf(s[r], 64.f)); const float rc = __builtin_amdgcn_rcpf(1.f + t), b = t * rc;
        if (DIAG) { const bool causal = ((r & 3) + 8 * (r >> 2) + 4 * hi) < qrel; R[r] = causal ? rc : 1.f; Bt[r] = causal ? b : 0.f; }
        else { R[r] = rc; Bt[r] = b; } }
    float tg[4], og[4];
#pragma unroll
    for (int g = 0; g < 4; ++g) { tg[g] = (R[4 * g] * R[4 * g + 1]) * (R[4 * g + 2] * R[4 * g + 3]);
        const unsigned x = __float_as_uint(tg[g]); auto rr = __builtin_amdgcn_permlane32_swap(x, x, false, false); og[g] = __uint_as_float(hi ? rr[0] : rr[1]); }
    float base[4]; float run = carry;
#pragma unroll
    for (int g = 3; g >= 0; --g) { base[g] = hi ? run : run * og[g]; run *= tg[g] * og[g]; }
    float w[16];
#pragma unroll
    for (int g = 0; g < 4; ++g) { float a = base[g];
#pragma unroll
        for (int i = 3; i >= 0; --i) { w[4 * g + i] = Bt[4 * g + i] * a; a *= R[4 * g + i]; } }
    carry = run;
#pragma unroll
    for (int s2 = 0; s2 < 2; ++s2) { pa[s2].x = pg8::cvt_pk_bf16(w[8 * s2], w[8 * s2 + 1]); pa[s2].y = pg8::cvt_pk_bf16(w[8 * s2 + 2], w[8 * s2 + 3]); pa[s2].z = pg8::cvt_pk_bf16(w[8 * s2 + 4], w[8 * s2 + 5]); pa[s2].w = pg8::cvt_pk_bf16(w[8 * s2 + 6], w[8 * s2 + 7]); }
}
__device__ __forceinline__ void attn_phase(const bf16* Q, const bf16* K, const bf16* V, bf16* O, int vcu, int G, int wave, int lane, LAS unsigned char* lds) {
    const int r32 = lane & 31, hi = lane >> 5;
    LAS unsigned char* vt = lds + wave * 8192;
    const unsigned vt_addr = (unsigned)(uintptr_t)vt;
    const unsigned tr_base = vt_addr + (unsigned)((4 * hi + ((lane & 15) >> 2)) * 128 + (16 * ((lane >> 4) & 1) + 4 * (lane & 3)) * 2);
    for (int wu = vcu; wu < NB * NH * (SEQ / 512); wu += G) {
        const int bh = wu / (SEQ / 512), qbA = ((wu % (SEQ / 512)) * 8 + wave) * 2, qbB = qbA + 1, b = bh / NH, h = bh % NH;
        const size_t rowbase = (size_t)b * SEQ; const int q0 = qbA * 32;
        bf16x8 qfA[4], qfB[4];
        { const bf16* Qw = Q + (rowbase + q0 + r32) * D + h * HD + hi * 8;
#pragma unroll
          for (int ks = 0; ks < 4; ++ks) { qfA[ks] = *(const bf16x8*)(Qw + ks * 16); qfB[ks] = *(const bf16x8*)(Qw + (size_t)32 * D + ks * 16); } }
        f32x16 oA0, oA1, oB0, oB1;
#pragma unroll
        for (int r = 0; r < 16; ++r) { oA0[r] = 0.f; oA1[r] = 0.f; oB0[r] = 0.f; oB1[r] = 0.f; }
        float carryA = 1.f, carryB = 1.f;
        bf16x8 k0[4], k1[4];
        { const bf16* Kw = K + (rowbase + (size_t)qbB * 32 + r32) * D + h * HD + hi * 8;
          v4u vfirst[4];
#pragma unroll
          for (int ks = 0; ks < 4; ++ks) k0[ks] = *(const bf16x8*)(Kw + ks * 16);
#pragma unroll
          for (int i = 0; i < 4; ++i) vfirst[i] = *(const v4u*)(V + (rowbase + (size_t)qbB * 32 + (lane >> 3) + 8 * i) * D + h * HD + (lane & 7) * 8);
#pragma unroll
          for (int i = 0; i < 4; ++i) *(LAS v4u*)(vt + ((lane >> 3) + 8 * i) * 128 + (lane & 7) * 16) = vfirst[i]; }
        auto tile = [&](auto mode, auto cur, int kt, const bf16x8 (&kc)[4], bf16x8 (&kn)[4]) __attribute__((always_inline)) -> bool {
            constexpr int MODE = decltype(mode)::value, CUR = decltype(cur)::value;
            v4u vnx[4];
            if (kt > 0) { const bf16* Kw = K + (rowbase + (size_t)(kt - 1) * 32 + r32) * D + h * HD + hi * 8;
#pragma unroll
                for (int ks = 0; ks < 4; ++ks) kn[ks] = *(const bf16x8*)(Kw + ks * 16);
#pragma unroll
                for (int i = 0; i < 4; ++i) vnx[i] = *(const v4u*)(V + (rowbase + (size_t)(kt - 1) * 32 + (lane >> 3) + 8 * i) * D + h * HD + (lane & 7) * 8); }
            f32x16 sB;
#pragma unroll
            for (int r = 0; r < 16; ++r) sB[r] = 0.f;
#pragma unroll
            for (int ks = 0; ks < 4; ++ks) sB = __builtin_amdgcn_mfma_f32_32x32x16_bf16(kc[ks], qfB[ks], sB, 0, 0, 0);
            v4u paB[2], paA[2];
            attn_tile<MODE == 0>(sB, r32, hi, carryB, paB);
            __builtin_amdgcn_sched_barrier(0);
            if (MODE >= 1) { f32x16 sA;
#pragma unroll
                for (int r = 0; r < 16; ++r) sA[r] = 0.f;
#pragma unroll
                for (int ks = 0; ks < 4; ++ks) sA = __builtin_amdgcn_mfma_f32_32x32x16_bf16(kc[ks], qfA[ks], sA, 0, 0, 0);
                attn_tile<MODE == 1>(sA, r32, hi, carryA, paA); }
            LDS_WAIT();
            __builtin_amdgcn_sched_barrier(0);
            s16x4 vlo[2][2], vhi[2][2];
#pragma unroll
            for (int s2 = 0; s2 < 2; ++s2)
#pragma unroll
                for (int db = 0; db < 2; ++db) {
                    asm volatile("ds_read_b64_tr_b16 %0, %1 offset:%c2" : "=v"(vlo[s2][db]) : "v"(tr_base), "i"(CUR * 4096 + s2 * 16 * 128 + db * 64) : "memory");
                    asm volatile("ds_read_b64_tr_b16 %0, %1 offset:%c2" : "=v"(vhi[s2][db]) : "v"(tr_base), "i"(CUR * 4096 + s2 * 16 * 128 + 8 * 128 + db * 64) : "memory"); }
            asm volatile("s_waitcnt lgkmcnt(0)" : "+v"(vlo[0][0]), "+v"(vlo[0][1]), "+v"(vlo[1][0]), "+v"(vlo[1][1]), "+v"(vhi[0][0]), "+v"(vhi[0][1]), "+v"(vhi[1][0]), "+v"(vhi[1][1]) :: "memory");
            __builtin_amdgcn_sched_barrier(0);
#pragma unroll
            for (int s2 = 0; s2 < 2; ++s2) {
                const bf16x8 v0 = (bf16x8){vlo[s2][0][0], vlo[s2][0][1], vlo[s2][0][2], vlo[s2][0][3], vhi[s2][0][0], vhi[s2][0][1], vhi[s2][0][2], vhi[s2][0][3]};
                const bf16x8 v1 = (bf16x8){vlo[s2][1][0], vlo[s2][1][1], vlo[s2][1][2], vlo[s2][1][3], vhi[s2][1][0], vhi[s2][1][1], vhi[s2][1][2], vhi[s2][1][3]};
                const bf16x8 pB = __builtin_bit_cast(bf16x8, paB[s2]);
                oB0 = __builtin_amdgcn_mfma_f32_32x32x16_bf16(pB, v0, oB0, 0, 0, 0);
                oB1 = __builtin_amdgcn_mfma_f32_32x32x16_bf16(pB, v1, oB1, 0, 0, 0);
                if (MODE >= 1) { const bf16x8 pA = __builtin_bit_cast(bf16x8, paA[s2]);
                    oA0 = __builtin_amdgcn_mfma_f32_32x32x16_bf16(pA, v0, oA0, 0, 0, 0);
                    oA1 = __builtin_amdgcn_mfma_f32_32x32x16_bf16(pA, v1, oA1, 0, 0, 0); }
            }
            if (kt > 0) {
#pragma unroll
                for (int i = 0; i < 4; ++i) *(LAS v4u*)(vt + (1 - CUR) * 4096 + ((lane >> 3) + 8 * i) * 128 + (lane & 7) * 16) = vnx[i]; }
            return MODE >= 1 && __all(fmaxf(carryA, carryB) < 1e-37f);
        };
        using I0 = std::integral_constant<int, 0>; using I1 = std::integral_constant<int, 1>; using I2 = std::integral_constant<int, 2>;
        (void)tile(I0{}, I0{}, qbB, k0, k1);
        bool done = tile(I1{}, I1{}, qbA, k1, k0);
        for (int kt = qbA - 1; !done && kt >= 0; kt -= 2) {
            done = tile(I2{}, I0{}, kt, k0, k1);
            if (done || kt == 0) break;
            done = tile(I2{}, I1{}, kt - 1, k1, k0);
        }
        LDS_WAIT();
#pragma unroll
        for (int r = 0; r < 16; ++r) { const int qr = (r & 3) + 8 * (r >> 2) + 4 * hi;
            *(LAS bf16*)(vt + qr * 128 + r32 * 2) = (bf16)f2bf(oA0[r]); *(LAS bf16*)(vt + qr * 128 + 64 + r32 * 2) = (bf16)f2bf(oA1[r]);
            *(LAS bf16*)(vt + 4096 + qr * 128 + r32 * 2) = (bf16)f2bf(oB0[r]); *(LAS bf16*)(vt + 4096 + qr * 128 + 64 + r32 * 2) = (bf16)f2bf(oB1[r]); }
        LDS_WAIT();
        { bf16* Ow = O + (rowbase + q0 + (lane >> 3)) * D + h * HD + (lane & 7) * 8;
#pragma unroll
          for (int i = 0; i < 8; ++i) *(v4u*)(Ow + (size_t)(8 * i) * D) = *(const LAS v4u*)(vt + ((lane >> 3) + 8 * i) * 128 + (lane & 7) * 16); }
        LDS_WAIT();
    }
}

#ifndef MK_N_LAUNCHES
#define MK_N_LAUNCHES 1
#endif
constexpr int N_PHASES = 19;
constexpr int N_LAUNCHES = MK_N_LAUNCHES;
static_assert(N_LAUNCHES == 1 || N_LAUNCHES == N_PHASES, "MK_N_LAUNCHES is 1 or 19");
enum { IN_X = 0, IN_NORM_MIX, IN_NORM_FFN, IN_CONV_W_IN, IN_CONV_K, IN_CONV_W_OUT, IN_NORM_KV, IN_W_KV, IN_ATTN_WQ, IN_ATTN_WO, IN_PEER_WQ, IN_PEER_SK, IN_PEER_U, IN_PEER_V, IN_NORM_FINAL, N_IN };
struct Args { const float* in[N_IN]; float* out; unsigned char* ws; int ph_lo, ph_hi; };

__global__ void __launch_bounds__(NWAVES * 64, 2) fwd_kernel(Args args) {
    extern __shared__ __attribute__((aligned(16))) unsigned char lds_raw[];
    LAS unsigned char* lds = (LAS unsigned char*)lds_raw;
    volatile LAS unsigned* MISC = (volatile LAS unsigned*)(lds + MISC_OFF);
    const int tid = threadIdx.x, lane = tid & 63, wave = __builtin_amdgcn_readfirstlane(tid >> 6);
    const int G = gridDim.x, bx = blockIdx.x;
    const int vcu = (G % 8 == 0) ? (bx % 8) * (G / 8) + bx / 8 : bx;
    const int gw = vcu * NWAVES + wave, NGW = G * NWAVES;
    unsigned char* ws = args.ws;
    gu32* ctl = (gu32*)(ws + WS_CTL);
    bf16* W1 = (bf16*)(ws + WS_W1); bf16* W2 = (bf16*)(ws + WS_W2); bf16* WQ0 = (bf16*)(ws + WS_WQ0); bf16* WQKV = (bf16*)(ws + WS_WQKV); bf16* WO = (bf16*)(ws + WS_WO); bf16* WQ1 = (bf16*)(ws + WS_WQ1);
    bf16* SK = (bf16*)(ws + WS_SK); bf16* XN = (bf16*)(ws + WS_XN); bf16* BIG = (bf16*)(ws + WS_BIG);
    unsigned char* UQ = ws + WS_UQ; unsigned char* VQ = ws + WS_VQ; float* SU = (float*)(ws + WS_SU); float* SV = (float*)(ws + WS_SV);
    signed char* XQ = (signed char*)(ws + WS_XQ); float* SX = (float*)(ws + WS_SX); float* RS = (float*)(ws + WS_SX + 512 * 1024); unsigned short* IDX = (unsigned short*)(ws + WS_IDX); _Float16* GATE = (_Float16*)(ws + WS_GATE); _Float16* COEF = (_Float16*)(ws + WS_ACT); float* SSQ4 = (float*)(ws + WS_SSQ4);
    bf16* Hb = (bf16*)(ws + WS_HB);
    for (int u = tid; u < (LDS_BYTES - LDSCTL_OFF) / 4; u += NWAVES * 64) ((LAS unsigned*)(lds + LDSCTL_OFF))[u] = 0u;
    __syncthreads();
    XcdBarrier bar; bar.bar = (unsigned*)(ctl + CW_BAR); bar.x = 0; bar.st = nullptr;
    if (N_LAUNCHES == 1) bar = xcd_barrier_post((unsigned*)(ctl + CW_BAR), MISC + 8);
    const int lo = args.ph_lo, hi = args.ph_hi;
#define PEER_BX bx
#define PEER_G  G
#define IN(k) (lo <= (k) && (k) < hi)
#define SEAM(k) do { if (IN(k) && IN((k) + 1)) xcd_barrier(bar); } while (0)

    if (IN(0)) {
        LAS float* scr = (LAS float*)(lds + RING_OFF + wave * 16384);
        constexpr int I_W1 = 16 * 96, I_W2 = 16 * 32, I_Q = 16 * 64, I_AQ = 16 * 32, I_KV = 16 * 64, I_O = 16 * 32;
        constexpr int I_F = 16 * 16 * 4;
        constexpr int NITEMS = 2 * I_F + I_W1 + I_W2 + I_AQ + I_KV + I_O;
        for (int it = gw; it < NITEMS; it += NGW) {
            int r = it;
            if (r < 2 * I_F) { const int ly = r / I_F; p0_fold_item(args.in[IN_PEER_WQ] + (size_t)ly * D * QPW, args.in[IN_PEER_SK] + (size_t)ly * PH * 2 * NKEYS * KD, args.in[IN_NORM_FFN] + (size_t)ly * D, ly ? WQ1 : WQ0, r % I_F, lane); continue; } r -= 2 * I_F;
            if (r < I_W1) { p0_transpose_item(args.in[IN_CONV_W_IN], D, 3 * D, W1, 0, scr, r, lane, args.in[IN_NORM_MIX], true); continue; } r -= I_W1;
            if (r < I_W2) { p0_transpose_item(args.in[IN_CONV_W_OUT], D, D, W2, 0, scr, r, lane, nullptr); continue; } r -= I_W2;
            if (r < I_AQ) { p0_transpose_item(args.in[IN_ATTN_WQ], D, D, WQKV, 0, scr, r, lane, args.in[IN_NORM_MIX] + D); continue; } r -= I_AQ;
            if (r < I_KV) { p0_transpose_item(args.in[IN_W_KV], D, 2 * D, WQKV, D, scr, r, lane, args.in[IN_NORM_KV]); continue; } r -= I_KV;
            p0_transpose_item(args.in[IN_ATTN_WO], D, D, WO, 0, scr, r, lane, nullptr);
        }
        const size_t gtid = (size_t)vcu * (NWAVES * 64) + tid, NT = (size_t)G * (NWAVES * 64);
        quant_u_phase(args.in[IN_PEER_U], args.in[IN_NORM_FFN], UQ, SU, gw, NGW, lane);
        quant_v_phase(args.in[IN_PEER_V], VQ, SV, gw, NGW, lane);
        norm_phase(args.in[IN_X], Hb, RS, gw, NGW, lane);
    }
    SEAM(0);
    if (IN(1)) {
        pg8::Gemm g{Hb, W1, M, 3 * D, D}; pg8::StaticOrder S; S.init(M, 3 * D, G, bx);
        pg8::EpiConvIn E{BIG, BIG + (size_t)M * D, RS};
        pg8::gemm_phase<pg8::EpiConvIn, pg8::StaticOrder, true, true>(lds + RING_OFF, g, S, E);
    }
    SEAM(1);
    if (IN(2)) conv_phase(BIG, BIG + (size_t)M * D, args.in[IN_CONV_K], XN, gw, NGW, lane);
    SEAM(2);
    if (IN(3)) {
        pg8::Gemm g{XN, W2, M, D, D}; pg8::StaticOrder S; S.init(M, D, G, bx);
        pg8::EpiBf16Res<false> E{Hb, Hb, D};
        pg8::gemm_phase<pg8::EpiBf16Res<false>, pg8::StaticOrder, true, true>(lds + RING_OFF, g, S, E);
    }
    SEAM(3);
    if (IN(4)) norm_q_phase(Hb, RS, XQ, SX, gw, NGW, lane);
    SEAM(4);
    if (IN(5)) {
        pg8::Gemm g{Hb, WQ0, M, QPW, D}; pg8::StaticOrder S; S.init(M, QPW, G, bx);
        pg8::EpiBf16 E{BIG, QPW, 0, 0, 1.f, RS, 0, 1};
        pg8::gemm_phase<pg8::EpiBf16, pg8::StaticOrder, true, true>(lds + RING_OFF, g, S, E);
    }
    SEAM(5);
    if (IN(6)) select_phase((const _Float16*)BIG, IDX, GATE, bx, G, wave, lane);
    SEAM(6);
    if (IN(7)) peer_u_phase(XQ, SX, IDX, GATE, UQ, SU, SV, COEF, PEER_BX, PEER_G, wave, lane, lds + RING_OFF);
    SEAM(7);
    if (IN(8)) peer_v_phase(COEF, IDX, VQ, Hb, SSQ4, PEER_BX, PEER_G, wave, lane, lds + RING_OFF);
    SEAM(8);
    if (IN(10)) {
        pg8::Gemm g{Hb, WQKV, M, 3 * D, D}; pg8::StaticOrder S; S.init(M, 3 * D, G, bx);
        pg8::EpiBf16 E{BIG, D, D, (size_t)M * D, 0.125f * 1.4426950408889634f, SSQ4, 1, 0};
        pg8::gemm_phase<pg8::EpiBf16, pg8::StaticOrder, true, true>(lds + RING_OFF, g, S, E);
    }
    SEAM(10);
    if (IN(11)) attn_phase(BIG, BIG + (size_t)M * D, BIG + (size_t)2 * M * D, XN, vcu, G, wave, lane, lds + RING_OFF);
    SEAM(11);
    if (IN(12)) {
        pg8::Gemm g{XN, WO, M, D, D}; pg8::StaticOrder S; S.init(M, D, G, bx);
        pg8::EpiBf16Res<false> E{Hb, Hb, D};
        pg8::gemm_phase<pg8::EpiBf16Res<false>, pg8::StaticOrder, true, true>(lds + RING_OFF, g, S, E);
    }
    SEAM(12);
    if (IN(13)) norm_q_phase(Hb, RS, XQ, SX, gw, NGW, lane);
    SEAM(13);
    if (IN(14)) {
        pg8::Gemm g{Hb, WQ1, M, QPW, D}; pg8::StaticOrder S; S.init(M, QPW, G, bx);
        pg8::EpiBf16 E{BIG, QPW, 0, 0, 1.f, RS, 0, 1};
        pg8::gemm_phase<pg8::EpiBf16, pg8::StaticOrder, true, true>(lds + RING_OFF, g, S, E);
    }
    SEAM(14);
    if (IN(15)) select_phase((const _Float16*)BIG, IDX, GATE, bx, G, wave, lane);
    SEAM(15);
    if (IN(16)) peer_u_phase(XQ, SX, IDX, GATE, UQ + (size_t)NEXP * (D / 2), SU + NEXP, SV + NEXP, COEF, PEER_BX, PEER_G, wave, lane, lds + RING_OFF);
    SEAM(16);
    if (IN(17)) peer_v_phase(COEF, IDX, VQ + (size_t)4 * NEXP * 128, Hb, SSQ4, PEER_BX, PEER_G, wave, lane, lds + RING_OFF);
    SEAM(17);
    if (IN(18)) final_norm_phase(Hb, SSQ4, args.in[IN_NORM_FINAL], args.out, gw, NGW, lane);
#undef IN
#undef SEAM
}

extern "C" void kernel_launch(void* const* d_in, const int* in_sizes, int n_in, void* d_out, int out_size, void* d_ws, size_t ws_size, hipStream_t stream) {
    static int grid = 0;
    if (grid == 0) {
        if (n_in != N_IN || in_sizes[0] != M * D || out_size != M * D || ws_size < WS_END) { fprintf(stderr, "kernel_launch: unexpected shapes (n_in %d, in0 %d, out %d, ws %zu); nothing launched\n", n_in, n_in > 0 ? in_sizes[0] : -1, out_size, ws_size); grid = -1; return; }
        int dev = 0, cus = 0, per_cu = 0;
        if (hipGetDevice(&dev) != hipSuccess || hipDeviceGetAttribute(&cus, hipDeviceAttributeMultiprocessorCount, dev) != hipSuccess) { fprintf(stderr, "kernel_launch: device query failed\n"); grid = -1; return; }
        if (hipFuncSetAttribute((const void*)fwd_kernel, hipFuncAttributeMaxDynamicSharedMemorySize, LDS_BYTES) != hipSuccess) { fprintf(stderr, "kernel_launch: hipFuncSetAttribute failed\n"); grid = -1; return; }
        if (hipOccupancyMaxActiveBlocksPerMultiprocessor(&per_cu, (const void*)fwd_kernel, NWAVES * 64, LDS_BYTES) != hipSuccess || per_cu < 1) fprintf(stderr, "kernel_launch: note: occupancy query reports %d workgroups per CU\n", per_cu);
        (void)hipGetLastError();
        grid = cus - (cus % 8);
        if (grid < 8) { fprintf(stderr, "kernel_launch: needs at least 8 workgroups\n"); grid = -1; return; }
    }
    if (grid < 0) return;
    if (hipMemsetAsync((char*)d_ws + WS_CTL, 0, CTL_ZERO_BYTES, stream) != hipSuccess) { fprintf(stderr, "kernel_launch: hipMemsetAsync failed\n"); return; }
    Args a{};
    for (int i = 0; i < N_IN; ++i) a.in[i] = (const float*)d_in[i];
    a.out = (float*)d_out; a.ws = (unsigned char*)d_ws;
    for (int li = 0; li < N_LAUNCHES; ++li) {
        a.ph_lo = (N_LAUNCHES == 1) ? 0 : li; a.ph_hi = (N_LAUNCHES == 1) ? N_PHASES : li + 1;
        hipLaunchKernelGGL(fwd_kernel, dim3(grid), dim3(NWAVES * 64), LDS_BYTES, stream, a);
        const hipError_t le = hipPeekAtLastError();
        if (le != hipSuccess) { fprintf(stderr, "kernel_launch: launch %d failed: %s\n", li, hipGetErrorName(le)); break; }
    }
}
```

```cpp
#include <hip/hip_runtime.h>
#include <cstdio>
#include <cstdint>
#include <type_traits>
namespace pg8 {
#define PG8_LAS __attribute__((address_space(3)))
typedef unsigned short bf16_t;
typedef short bf16x8 __attribute__((ext_vector_type(8)));
typedef float f32x4 __attribute__((ext_vector_type(4)));
typedef unsigned u32x4 __attribute__((ext_vector_type(4)));
constexpr int BM = 256, BK = 64, HALF = 128, HTB = HALF * BK * 2  , STAGE_BYTES = 8 * HTB, NXCD = 8, WGM = 8;

__host__ __device__ __forceinline__ int lds_byte(int r, int c) { const int st = (r >> 4) * 2 + (c >> 5), rr = r & 15, cc = c & 31, ob = rr * 64 + cc * 2; return st * 1024 + (ob ^ (((ob >> 9) & 1) << 5)); }
__host__ __device__ __forceinline__ void stage_rc(int b, int& R, int& C) { const int st = b / 1024, sb = b % 1024, swz = sb ^ (((sb >> 9) & 1) << 5); R = (st >> 1) * 16 + swz / 64; C = (st & 1) * 32 + (swz % 64) / 2; }
__host__ __device__ __forceinline__ int perm32(int rho) { const int n = rho >> 4, i = rho & 15; return 8 * (i >> 2) + 4 * n + (i & 3); }

struct Unit { int pm, pn; };
struct Gemm { const bf16_t* A; const bf16_t* Bt; int M, N, K; };

struct StaticOrder {
    int nM, nN, nwg, G, c;
    __host__ __device__ void init(int M, int N, int G_, int c_) { nM = M / BM; nN = N / BM; nwg = nM * nN; G = G_; c = c_; }
    __host__ __device__ bool next(int i, Unit& u) const {
        const long L = (long)i * G + c; if (L >= nwg) return false;
        int wgid = (int)L; { const int q = nwg / NXCD, r = nwg % NXCD, xcd = wgid % NXCD, off = wgid / NXCD; wgid = (xcd < r ? xcd * (q + 1) : r * (q + 1) + (xcd - r) * q) + off; }
        const int nig = WGM * nN, gid = wgid / nig, fm = gid * WGM, gsz = (nM - fm) < WGM ? (nM - fm) : WGM;
        u.pm = fm + ((wgid % nig) % gsz); u.pn = (wgid % nig) / gsz; return true;
    }
    __device__ __forceinline__ void a_ready(const Unit&) const {}
    __device__ __forceinline__ void done(const Unit&) const {}
};

__device__ __forceinline__ unsigned cvt_pk_f16(float lo, float hi) { typedef _Float16 h2_t __attribute__((ext_vector_type(2))); const h2_t t = (h2_t){(_Float16)lo, (_Float16)hi}; return __builtin_bit_cast(unsigned, t); }
__device__ __forceinline__ unsigned cvt_pk_bf16(float lo, float hi) { unsigned r; asm volatile("v_cvt_pk_bf16_f32 %0, %1, %2" : "=v"(r) : "v"(lo), "v"(hi)); return r; }
typedef float f32x2 __attribute__((ext_vector_type(2)));

struct EpiBf16 {
    static constexpr bool PERM = true, AFTER_DRAIN = false;
    bf16_t* O; int ldc; int split_cols; size_t split_stride; float scale0; const float* rs; int ssq4; int f16out;
    __device__ __forceinline__ void operator()(const f32x4 (&acc)[2][2][4][2], const Unit& u, int wr, int wc, int fr, int fq) const {
        const int row0 = u.pm * BM + wr * 64 + fr; int colt = u.pn * BM; bf16_t* base = O;
        float sc = 1.f; if (split_cols) { const int t = colt / split_cols; base += (size_t)t * split_stride; colt -= t * split_cols; if (t == 0) sc = scale0; }
        const int col0 = colt + wc * 32 + 8 * fq;
#pragma unroll
        for (int ai = 0; ai < 2; ++ai)
#pragma unroll
          for (int mp = 0; mp < 2; ++mp) {
            float scrv[2];
#pragma unroll
            for (int mm = 0; mm < 2; ++mm) { const int m = 2 * mp + mm; float scr = sc;
                if (rs) { const int rr = row0 + ai * HALF + m * 16; if (ssq4) { const f32x4* qp = (const f32x4*)(rs + 16 * (size_t)rr); const f32x4 q0 = qp[0], q1 = qp[1], q2 = qp[2], q3 = qp[3];
                    const float t = (((q0[0] + q0[1]) + (q0[2] + q0[3])) + ((q1[0] + q1[1]) + (q1[2] + q1[3]))) + (((q2[0] + q2[1]) + (q2[2] + q2[3])) + ((q3[0] + q3[1]) + (q3[2] + q3[3]))); scr = sc / sqrtf(t * (1.f / 1024.f) + 1e-6f); } else scr = sc * rs[rr]; }
                scrv[mm] = scr; }
            asm volatile("" ::: "memory");
#pragma unroll
            for (int mm = 0; mm < 2; ++mm) { const int m = 2 * mp + mm; bf16_t* rowp = base + (size_t)(row0 + ai * HALF + m * 16) * ldc + col0; const float scr = scrv[mm];
#pragma unroll
                for (int bj = 0; bj < 2; ++bj) { const f32x4 v0 = acc[ai][bj][m][0] * scr, v1 = acc[ai][bj][m][1] * scr;
                    u32x4 w;
                    if (f16out) { w.x = cvt_pk_f16(v0[0], v0[1]); w.y = cvt_pk_f16(v0[2], v0[3]); w.z = cvt_pk_f16(v1[0], v1[1]); w.w = cvt_pk_f16(v1[2], v1[3]); }
                    else { w.x = cvt_pk_bf16(v0[0], v0[1]); w.y = cvt_pk_bf16(v0[2], v0[3]); w.z = cvt_pk_bf16(v1[0], v1[1]); w.w = cvt_pk_bf16(v1[2], v1[3]); }
                    *(u32x4*)(rowp + bj * HALF) = w; } }
            asm volatile("" ::: "memory"); }
    }
};
struct EpiConvIn {
    static constexpr bool PERM = true, AFTER_DRAIN = false;
    bf16_t* Bo; bf16_t* Uo; const float* rs;
    __device__ __forceinline__ void operator()(const f32x4 (&acc)[2][2][4][2], const Unit& u, int wr, int wc, int fr, int fq) const {
        const int row0 = u.pm * BM + wr * 64 + fr;
        if (u.pn < 4) { const int col0 = u.pn * BM + wc * 32 + 8 * fq;
#pragma unroll
            for (int ai = 0; ai < 2; ++ai)
#pragma unroll
                for (int m = 0; m < 4; ++m) { bf16_t* rowp = Bo + (size_t)(row0 + ai * HALF + m * 16) * 1024 + col0; const float r = rs[row0 + ai * HALF + m * 16];
#pragma unroll
                    for (int bj = 0; bj < 2; ++bj) { const f32x4 v0 = acc[ai][bj][m][0] * r, v1 = acc[ai][bj][m][1] * r;
                        u32x4 w; w.x = cvt_pk_bf16(v0[0], v0[1]); w.y = cvt_pk_bf16(v0[2], v0[3]); w.z = cvt_pk_bf16(v1[0], v1[1]); w.w = cvt_pk_bf16(v1[2], v1[3]);
                        *(u32x4*)(rowp + bj * HALF) = w; } }
        } else { const int col0 = (u.pn - 4) * HALF + wc * 32 + 8 * fq;
#pragma unroll
            for (int ai = 0; ai < 2; ++ai)
#pragma unroll
                for (int m = 0; m < 4; ++m) { const float r = rs[row0 + ai * HALF + m * 16], r2 = r * r; const f32x4 v0 = acc[ai][0][m][0] * acc[ai][1][m][0] * r2, v1 = acc[ai][0][m][1] * acc[ai][1][m][1] * r2;
                    u32x4 w; w.x = cvt_pk_bf16(v0[0], v0[1]); w.y = cvt_pk_bf16(v0[2], v0[3]); w.z = cvt_pk_bf16(v1[0], v1[1]); w.w = cvt_pk_bf16(v1[2], v1[3]);
                    *(u32x4*)(Uo + (size_t)(row0 + ai * HALF + m * 16) * 1024 + col0) = w; }
        }
    }
};
template <bool RF32> struct EpiBf16Res {
    static constexpr bool PERM = true, AFTER_DRAIN = false;
    const void* R; bf16_t* O; int ldc;
    __device__ __forceinline__ void operator()(const f32x4 (&acc)[2][2][4][2], const Unit& u, int wr, int wc, int fr, int fq) const {
        const int row0 = u.pm * BM + wr * 64 + fr, col0 = u.pn * BM + wc * 32 + 8 * fq;
#pragma unroll
        for (int ai = 0; ai < 2; ++ai)
#pragma unroll
            for (int m = 0; m < 4; ++m) { const size_t off = (size_t)(row0 + ai * HALF + m * 16) * ldc + col0;
                f32x4 r0[2], r1[2];
#pragma unroll
                for (int bj = 0; bj < 2; ++bj) {
                    if (RF32) { r0[bj] = *(const f32x4*)((const float*)R + off + bj * HALF); r1[bj] = *(const f32x4*)((const float*)R + off + bj * HALF + 4); }
                    else { const u32x4 w = *(const u32x4*)((const bf16_t*)R + off + bj * HALF);
                        r0[bj] = (f32x4){__uint_as_float(w.x << 16), __uint_as_float(w.x & 0xffff0000u), __uint_as_float(w.y << 16), __uint_as_float(w.y & 0xffff0000u)};
                        r1[bj] = (f32x4){__uint_as_float(w.z << 16), __uint_as_float(w.z & 0xffff0000u), __uint_as_float(w.w << 16), __uint_as_float(w.w & 0xffff0000u)}; } }
#pragma unroll
                for (int bj = 0; bj < 2; ++bj) { const f32x4 v0 = acc[ai][bj][m][0] + r0[bj], v1 = acc[ai][bj][m][1] + r1[bj];
                    u32x4 w; w.x = cvt_pk_bf16(v0[0], v0[1]); w.y = cvt_pk_bf16(v0[2], v0[3]); w.z = cvt_pk_bf16(v1[0], v1[1]); w.w = cvt_pk_bf16(v1[2], v1[3]);
                    *(u32x4*)(O + off + bj * HALF) = w; }
                if (m & 1) asm volatile("" ::: "memory"); }
    }
};

template <class Epi, class Sched, bool ALIGN_EPI = false, bool SP2 = false>
__device__ __forceinline__ void gemm_phase(PG8_LAS unsigned char* lds, const Gemm g, const Sched& S, const Epi& E) {
    const int tid = threadIdx.x, wid = __builtin_amdgcn_readfirstlane(tid >> 6), lane = tid & 63, wr = wid >> 2, wc = wid & 3, fr = lane & 15, fq = lane >> 4;
    const int K = g.K, nt = K / BK;
    unsigned voffA[2], voffB[2];
#pragma unroll
    for (int i = 0; i < 2; ++i) { int R, C; stage_rc(tid * 16 + i * 8192, R, C); const int Rb = Epi::PERM ? ((R & ~31) + perm32(R & 31)) : R;
        voffA[i] = (unsigned)(R * K + C) * 2u; voffB[i] = (unsigned)(Rb * K + C) * 2u; }
    const size_t kstep = (size_t)(BK * 2);
    const size_t hstep = (size_t)HALF * K * 2;
    const size_t tstep = 2 * hstep;
    const unsigned ldsw = (unsigned)wid * 1024u;
    const int aoff = lds_byte(wr * 64 + fr, fq * 8), boff = lds_byte(wc * 32 + fr, fq * 8);
#define PG8_SA(b, h) (((b) * 2 + (h)) * HTB)
#define PG8_SB(b, h) ((4 + (b) * 2 + (h)) * HTB)
#define PG8_STAGE(bufoff, gbase, voff) do { _Pragma("unroll") for (int _i = 0; _i < 2; ++_i) \
        __builtin_amdgcn_global_load_lds((const unsigned*)((const char*)(gbase) + (voff)[_i]), (PG8_LAS unsigned*)(lds + (bufoff) + ldsw + _i * 8192), 16, 0, 0); } while (0)
#define PG8_LDA(dst, b, h) do { _Pragma("unroll") for (int m = 0; m < 4; ++m) _Pragma("unroll") for (int k = 0; k < 2; ++k) dst[m][k] = *(const PG8_LAS bf16x8*)(lds + PG8_SA(b, h) + aoff + m * 2048 + k * 1024); } while (0)
#define PG8_LDB(dst, b, h) do { _Pragma("unroll") for (int n = 0; n < 2; ++n) _Pragma("unroll") for (int k = 0; k < 2; ++k) dst[n][k] = *(const PG8_LAS bf16x8*)(lds + PG8_SB(b, h) + boff + n * 2048 + k * 1024); } while (0)
#define PG8_MMA(ai, bj, At, Bt) do { __builtin_amdgcn_s_setprio(1); _Pragma("unroll") for (int m = 0; m < 4; ++m) _Pragma("unroll") for (int n = 0; n < 2; ++n) _Pragma("unroll") for (int k = 0; k < 2; ++k) \
        acc[ai][bj][m][n] = __builtin_amdgcn_mfma_f32_16x16x32_bf16(Bt[n][k], At[m][k], acc[ai][bj][m][n], 0, 0, 0); __builtin_amdgcn_s_setprio(0); } while (0)
#define PG8_WAIT_V(n) asm volatile("s_waitcnt vmcnt(" #n ")" ::: "memory")
#define PG8_WAIT_L(n) asm volatile("s_waitcnt lgkmcnt(" #n ")" ::: "memory")
#define PG8_BAR __builtin_amdgcn_s_barrier()
#define PG8_SCHED __builtin_amdgcn_sched_barrier(0)
    Unit cur, nxt; int ui = 0;
    if (!S.next(0, cur)) return;
    f32x4 acc[2][2][4][2];
#pragma unroll
    for (int a = 0; a < 2; ++a)
#pragma unroll
        for (int b = 0; b < 2; ++b)
#pragma unroll
            for (int m = 0; m < 4; ++m)
#pragma unroll
                for (int n = 0; n < 2; ++n) acc[a][b][m][n] = (f32x4){0.f, 0.f, 0.f, 0.f};
    bf16x8 At[4][2], B0[2][2], B1[2][2];
    const char* cA = (const char*)g.A + (size_t)cur.pm * tstep; const char* cB = (const char*)g.Bt + (size_t)cur.pn * tstep;
    S.a_ready(cur);
    if constexpr (SP2) {
        PG8_STAGE(PG8_SB(0, 0), cB, voffB); PG8_STAGE(PG8_SB(0, 1), cB + hstep, voffB); PG8_STAGE(PG8_SA(0, 0), cA, voffA); PG8_STAGE(PG8_SA(0, 1), cA + hstep, voffA);
        if (wr == 1) PG8_BAR;
        PG8_WAIT_V(2); PG8_BAR;
        PG8_STAGE(PG8_SB(1, 0), cB + kstep, voffB); PG8_STAGE(PG8_SA(1, 0), cA + kstep, voffA); PG8_STAGE(PG8_SB(1, 1), cB + hstep + kstep, voffB);
        PG8_WAIT_V(6); PG8_BAR;
    } else {
        PG8_STAGE(PG8_SB(0, 0), cB, voffB); PG8_STAGE(PG8_SA(0, 0), cA, voffA); PG8_STAGE(PG8_SB(0, 1), cB + hstep, voffB); PG8_STAGE(PG8_SA(0, 1), cA + hstep, voffA);
        if (wr == 1) PG8_BAR;
        PG8_WAIT_V(4); PG8_BAR;
        PG8_STAGE(PG8_SB(1, 0), cB + kstep, voffB); PG8_STAGE(PG8_SA(1, 0), cA + kstep, voffA); PG8_STAGE(PG8_SB(1, 1), cB + hstep + kstep, voffB);
        PG8_WAIT_V(6); PG8_BAR;
    }
    for (;;) {
        const bool has_next = S.next(ui + 1, nxt);
        const char* nA = has_next ? (const char*)g.A + (size_t)nxt.pm * tstep : cA; const char* nB = has_next ? (const char*)g.Bt + (size_t)nxt.pn * tstep : cB;
        for (int t = 0; t < nt; t += 2) {
            const bool last = (t == nt - 2);
            const char* a1 = cA + (size_t)(t + 1) * kstep;
            const char* a2 = last ? nA : cA + (size_t)(t + 2) * kstep; const char* b2 = last ? nB : cB + (size_t)(t + 2) * kstep;
            const char* a3 = a2 + kstep; const char* b3 = b2 + kstep;
            if (last && has_next) S.a_ready(nxt);
            if constexpr (SP2) {
            PG8_LDB(B0, 0, 0); PG8_LDB(B1, 0, 1); PG8_SCHED; PG8_LDA(At, 0, 0); PG8_STAGE(PG8_SA(1, 1), a1 + hstep, voffA);
            PG8_WAIT_V(8); PG8_WAIT_L(0); PG8_BAR; PG8_MMA(0, 0, At, B0); PG8_MMA(0, 1, At, B1); PG8_BAR; PG8_SCHED;
            PG8_LDA(At, 0, 1); PG8_STAGE(PG8_SB(0, 0), b2, voffB); PG8_STAGE(PG8_SB(0, 1), b2 + hstep, voffB); PG8_STAGE(PG8_SA(0, 0), a2, voffA);
            PG8_WAIT_V(8); PG8_WAIT_L(0); PG8_BAR; PG8_MMA(1, 0, At, B0); PG8_MMA(1, 1, At, B1); PG8_BAR; PG8_SCHED;
            PG8_LDB(B0, 1, 0); PG8_LDB(B1, 1, 1); PG8_SCHED; PG8_LDA(At, 1, 0); PG8_STAGE(PG8_SA(0, 1), a2 + hstep, voffA);
            PG8_WAIT_V(8); PG8_WAIT_L(0); PG8_BAR; PG8_MMA(0, 0, At, B0); PG8_MMA(0, 1, At, B1); PG8_BAR; PG8_SCHED;
            PG8_LDA(At, 1, 1); PG8_STAGE(PG8_SB(1, 0), b3, voffB); PG8_STAGE(PG8_SB(1, 1), b3 + hstep, voffB); PG8_STAGE(PG8_SA(1, 0), a3, voffA);
            PG8_WAIT_V(8); PG8_WAIT_L(0); PG8_BAR; PG8_MMA(1, 0, At, B0); PG8_MMA(1, 1, At, B1); PG8_BAR; PG8_SCHED;
            } else {
            PG8_LDB(B0, 0, 0); PG8_SCHED; PG8_LDA(At, 0, 0); PG8_STAGE(PG8_SA(1, 1), a1 + hstep, voffA);
            PG8_WAIT_L(8); PG8_BAR; PG8_WAIT_L(0); PG8_MMA(0, 0, At, B0); PG8_BAR; PG8_SCHED;
            PG8_LDB(B1, 0, 1); PG8_STAGE(PG8_SB(0, 0), b2, voffB);
            PG8_BAR; PG8_WAIT_L(0); PG8_MMA(0, 1, At, B1); PG8_BAR;
            PG8_LDA(At, 0, 1); PG8_STAGE(PG8_SA(0, 0), a2, voffA);
            PG8_BAR; PG8_WAIT_L(0); PG8_MMA(1, 0, At, B0); PG8_BAR; PG8_SCHED;
            PG8_STAGE(PG8_SB(0, 1), b2 + hstep, voffB);
            PG8_WAIT_V(6); PG8_BAR; PG8_MMA(1, 1, At, B1); PG8_BAR;
            PG8_LDB(B0, 1, 0); PG8_SCHED; PG8_LDA(At, 1, 0); PG8_STAGE(PG8_SA(0, 1), a2 + hstep, voffA);
            PG8_WAIT_L(8); PG8_BAR; PG8_WAIT_L(0); PG8_MMA(0, 0, At, B0); PG8_BAR; PG8_SCHED;
            PG8_LDB(B1, 1, 1); PG8_STAGE(PG8_SB(1, 0), b3, voffB);
            PG8_BAR; PG8_WAIT_L(0); PG8_MMA(0, 1, At, B1); PG8_BAR;
            PG8_LDA(At, 1, 1); PG8_STAGE(PG8_SA(1, 0), a3, voffA);
            PG8_BAR; PG8_WAIT_L(0); PG8_MMA(1, 0, At, B0); PG8_BAR; PG8_SCHED;
            PG8_STAGE(PG8_SB(1, 1), b3 + hstep, voffB);
            PG8_WAIT_V(6); PG8_BAR; PG8_MMA(1, 1, At, B1); PG8_BAR;
            }
        }
        if constexpr (ALIGN_EPI) { if (wr == 0) PG8_BAR; }
        if constexpr (!Epi::AFTER_DRAIN) { E(acc, cur, wr, wc, fr, fq); S.done(cur); }
        if (!has_next) break;
#pragma unroll
        for (int a = 0; a < 2; ++a)
#pragma unroll
            for (int b = 0; b < 2; ++b)
#pragma unroll
                for (int m = 0; m < 4; ++m)
#pragma unroll
                    for (int n = 0; n < 2; ++n) acc[a][b][m][n] = (f32x4){0.f, 0.f, 0.f, 0.f};
        cur = nxt; cA = nA; cB = nB; ++ui;
        if constexpr (ALIGN_EPI) { if (wr == 1) PG8_BAR; }
    }
    PG8_WAIT_V(0);
    if constexpr (!ALIGN_EPI) { if (wr == 0) PG8_BAR; }
    PG8_BAR;
    if constexpr (Epi::AFTER_DRAIN) { E.fused(acc, cur, wr, wc, fr, fq, lds, wid, lane); S.done(cur); }
#undef PG8_SA
#undef PG8_SB
#undef PG8_STAGE
#undef PG8_LDA
#undef PG8_LDB
#undef PG8_MMA
#undef PG8_WAIT_V
#undef PG8_WAIT_L
#undef PG8_BAR
#undef PG8_SCHED
}
}

constexpr int NB = 8, SEQ = 8192, D = 1024, M = NB * SEQ;
constexpr int NH = 16, HD = 64;
constexpr int PH = 8, NKEYS = 128, KD = 128, TOPK = 16, NEXP = NKEYS * NKEYS, QPW = PH * 2 * KD;
constexpr float RMS_EPS = 1e-6f;
constexpr int NWAVES = 8;

constexpr size_t MiB = 1u << 20;
constexpr size_t WS_CTL = 0, CTL_ZERO_BYTES = 1 * MiB;
constexpr size_t WS_W1 = 1 * MiB;
constexpr size_t WS_W2 = 7 * MiB;
constexpr size_t WS_WQ0 = 9 * MiB;
constexpr size_t WS_WQKV = 13 * MiB;
constexpr size_t WS_WO = 19 * MiB;
constexpr size_t WS_WQ1 = 21 * MiB;
constexpr size_t WS_SK = 25 * MiB;
constexpr size_t WS_UQ = 32 * MiB;
constexpr size_t WS_VQ = 64 * MiB;
constexpr size_t WS_SU = 96 * MiB, WS_SV = 96 * MiB + 256 * 1024;
constexpr size_t WS_XQ = 98 * MiB;
constexpr size_t WS_SX = 162 * MiB;
constexpr size_t WS_IDX = 163 * MiB;
constexpr size_t WS_GATE = 179 * MiB;
constexpr size_t WS_ACT = 211 * MiB;
constexpr size_t WS_SSQ4 = 244 * MiB;
constexpr size_t WS_XN = 256 * MiB;
constexpr size_t WS_BIG = 384 * MiB;
constexpr size_t WS_HB = 768 * MiB;
constexpr size_t WS_END = 896 * MiB;
constexpr int CW_BAR = 4096;

constexpr int RING_OFF = 0, RING_BYTES = 131072;
constexpr int LDSCTL_OFF = RING_BYTES, MISC_OFF = LDSCTL_OFF + 320;
constexpr int LDS_BYTES = 147456;
static_assert(MISC_OFF + 128 <= LDS_BYTES, "LDS map");

#define GAS __attribute__((address_space(1)))
#define LAS __attribute__((address_space(3)))
typedef unsigned short bf16;
typedef unsigned v4u __attribute__((ext_vector_type(4)));
typedef unsigned v2u __attribute__((ext_vector_type(2)));
typedef float f32x4 __attribute__((ext_vector_type(4)));
typedef float f32x16 __attribute__((ext_vector_type(16)));
typedef short bf16x8 __attribute__((ext_vector_type(8)));
typedef short s16x4 __attribute__((ext_vector_type(4)));
typedef __bf16 bf2_t __attribute__((ext_vector_type(2)));
typedef GAS unsigned gu32;
#define RLX_AGENT __ATOMIC_RELAXED, __HIP_MEMORY_SCOPE_AGENT
#define LDS_WAIT() asm volatile("s_waitcnt lgkmcnt(0)" ::: "memory")
#define VM_WAIT() asm volatile("s_waitcnt vmcnt(0)" ::: "memory")
__device__ __forceinline__ unsigned pk2(float lo, float hi);
__device__ __forceinline__ unsigned f2bf(float f) { return pk2(f, 0.f) & 0xffffu; }
__device__ __forceinline__ unsigned pk2(float lo, float hi) { unsigned r; asm("v_cvt_pk_bf16_f32 %0, %1, %2" : "=v"(r) : "v"(lo), "v"(hi)); return r; }
__device__ __forceinline__ float bflo(unsigned w) { return __uint_as_float(w << 16); }
__device__ __forceinline__ float bfhi(unsigned w) { return __uint_as_float(w & 0xffff0000u); }

#define XB_TMO      128
#define XB_XCNT(j)  (256  + 64 * (j))
#define XB_XSUB(j)  (1280 + 64 * (j))
#define XB_XGEN(j)  (2304 + 64 * (j))
#define XB_TOP      3328
#define XB_TOPGEN   3392
#define XCD_BAR_WORDS 3456
#define XB_SPIN_CAP (1u << 18)

__device__ __forceinline__ unsigned xb_ld(unsigned* p)              { return __hip_atomic_load(p, __ATOMIC_RELAXED, __HIP_MEMORY_SCOPE_AGENT); }
__device__ __forceinline__ unsigned xb_add(unsigned* p, unsigned v) { return __hip_atomic_fetch_add(p, v, __ATOMIC_RELAXED, __HIP_MEMORY_SCOPE_AGENT); }
__device__ __forceinline__ unsigned xb_xcc_id() { return (unsigned)__builtin_amdgcn_s_getreg((3 << 11) | 20) & 0xFu; }
#define XB_SPIN(cond, bar) do { unsigned _sp = 0; while (cond) { __builtin_amdgcn_s_sleep(1); \
    if ((++_sp & 255u) == 0u) { if (xb_ld(&(bar)[XB_TMO])) break; if (_sp > XB_SPIN_CAP) { atomicAdd(&(bar)[XB_TMO], 1u); break; } } } } while (0)

struct XcdBarrier {
    unsigned* bar; unsigned x;
    volatile LAS unsigned* st;
};

__device__ __forceinline__ XcdBarrier xcd_barrier_post(unsigned* bar, volatile LAS unsigned* st) {
    XcdBarrier b; b.bar = bar; b.x = xb_xcc_id(); b.st = st;
    if (threadIdx.x == 0) (void)xb_add(&bar[XB_XCNT(b.x)], 1u);
    return b;
}
__device__ __forceinline__ void xcd_barrier_complete(unsigned* bar, unsigned x, unsigned& nloc, unsigned& nx) {
    const unsigned G = gridDim.x * gridDim.y * gridDim.z;
    unsigned sum, cnt, mine, sp = 0u;
    for (;;) {
        sum = 0u; cnt = 0u; mine = 0u;
#pragma unroll
        for (unsigned j = 0; j < 16; ++j) { const unsigned c = xb_ld(&bar[XB_XCNT(j)]); sum += c; cnt += (c > 0u) ? 1u : 0u; mine = (j == x) ? c : mine; }
        if (sum == G) break;
        __builtin_amdgcn_s_sleep(1);
        if ((++sp & 255u) == 0u) { if (xb_ld(&bar[XB_TMO])) break; if (sp > XB_SPIN_CAP) { atomicAdd(&bar[XB_TMO], 1u); break; } }
    }
    nloc = mine > 0u ? mine : 1u; nx = cnt > 0u ? cnt : 1u;
}

__device__ __forceinline__ void xcd_barrier(const XcdBarrier& b) {
    asm volatile("s_waitcnt vmcnt(0)" ::: "memory");
    __syncthreads();
    if (threadIdx.x == 0) {
        unsigned* bar = b.bar;
        __builtin_amdgcn_s_waitcnt(0);
        unsigned nloc = b.st[0], nx = b.st[1];
        if (nloc == 0u) { xcd_barrier_complete(bar, b.x, nloc, nx); b.st[0] = nloc; b.st[1] = nx; }
        const unsigned old = xb_add(&bar[XB_XSUB(b.x)], 1u);
        const unsigned gen = old / nloc;
        if (old + 1u == (gen + 1u) * nloc) {
            __builtin_amdgcn_fence(__ATOMIC_RELEASE, "agent");
            asm volatile("s_waitcnt vmcnt(0)" ::: "memory");
            const unsigned og = xb_add(&bar[XB_TOP], 1u);
            const unsigned tg = og / nx;
            if (og + 1u == (tg + 1u) * nx) xb_add(&bar[XB_TOPGEN], 1u);
            else XB_SPIN(xb_ld(&bar[XB_TOPGEN]) == tg, bar);
            __builtin_amdgcn_fence(__ATOMIC_ACQUIRE, "agent");
            xb_add(&bar[XB_XGEN(b.x)], 1u);
            asm volatile("s_waitcnt vmcnt(0)" ::: "memory");
        } else {
            XB_SPIN(xb_ld(&bar[XB_XGEN(b.x)]) == gen, bar);
            __builtin_amdgcn_fence(__ATOMIC_ACQUIRE, "agent");
            asm volatile("s_waitcnt vmcnt(0)" ::: "memory");
        }
    }
    __syncthreads();
}

__device__ __forceinline__ float wave_sum(float v) {
#pragma unroll
    for (int o = 1; o < 64; o <<= 1) v += __shfl_xor(v, o);
    return v;
}
__device__ __forceinline__ float row16_sum(float s) {
    s += __builtin_amdgcn_update_dpp(0.f, s, 0xB1, 0xF, 0xF, true);
    s += __builtin_amdgcn_update_dpp(0.f, s, 0x4E, 0xF, 0xF, true);
    s += __builtin_amdgcn_update_dpp(0.f, s, 0x141, 0xF, 0xF, true);
    s += __builtin_amdgcn_update_dpp(0.f, s, 0x140, 0xF, 0xF, true);
    return s;
}
__device__ __forceinline__ float fmax_s(float a, float b) { float r; asm("v_max_f32_e32 %0, %1, %2" : "=v"(r) : "v"(a), "v"(b)); return r; }
__device__ __forceinline__ float fmin_s(float a, float b) { float r; asm("v_min_f32_e32 %0, %1, %2" : "=v"(r) : "v"(a), "v"(b)); return r; }
__device__ __forceinline__ float opq(float x) { asm("" : "+v"(x)); return x; }
__device__ __forceinline__ int opq(int x) { asm("" : "+v"(x)); return x; }
#define CE_DESC(a, b) do { const float _h = fmax_s(a, b), _l = fmin_s(a, b); a = _h; b = _l; } while (0)
template <int OFF, int N> __device__ __forceinline__ void sort16(float (&v)[N]) {
    CE_DESC(v[OFF + 0], v[OFF + 1]);
    CE_DESC(v[OFF + 2], v[OFF + 3]);
    CE_DESC(v[OFF + 0], v[OFF + 2]);
    CE_DESC(v[OFF + 1], v[OFF + 3]);
    CE_DESC(v[OFF + 1], v[OFF + 2]);
    CE_DESC(v[OFF + 4], v[OFF + 5]);
    CE_DESC(v[OFF + 6], v[OFF + 7]);
    CE_DESC(v[OFF + 4], v[OFF + 6]);
    CE_DESC(v[OFF + 5], v[OFF + 7]);
    CE_DESC(v[OFF + 5], v[OFF + 6]);
    CE_DESC(v[OFF + 0], v[OFF + 4]);
    CE_DESC(v[OFF + 2], v[OFF + 6]);
    CE_DESC(v[OFF + 2], v[OFF + 4]);
    CE_DESC(v[OFF + 1], v[OFF + 5]);
    CE_DESC(v[OFF + 3], v[OFF + 7]);
    CE_DESC(v[OFF + 3], v[OFF + 5]);
    CE_DESC(v[OFF + 1], v[OFF + 2]);
    CE_DESC(v[OFF + 3], v[OFF + 4]);
    CE_DESC(v[OFF + 5], v[OFF + 6]);
    CE_DESC(v[OFF + 8], v[OFF + 9]);
    CE_DESC(v[OFF + 10], v[OFF + 11]);
    CE_DESC(v[OFF + 8], v[OFF + 10]);
    CE_DESC(v[OFF + 9], v[OFF + 11]);
    CE_DESC(v[OFF + 9], v[OFF + 10]);
    CE_DESC(v[OFF + 12], v[OFF + 13]);
    CE_DESC(v[OFF + 14], v[OFF + 15]);
    CE_DESC(v[OFF + 12], v[OFF + 14]);
    CE_DESC(v[OFF + 13], v[OFF + 15]);
    CE_DESC(v[OFF + 13], v[OFF + 14]);
    CE_DESC(v[OFF + 8], v[OFF + 12]);
    CE_DESC(v[OFF + 10], v[OFF + 14]);
    CE_DESC(v[OFF + 10], v[OFF + 12]);
    CE_DESC(v[OFF + 9], v[OFF + 13]);
    CE_DESC(v[OFF + 11], v[OFF + 15]);
    CE_DESC(v[OFF + 11], v[OFF + 13]);
    CE_DESC(v[OFF + 9], v[OFF + 10]);
    CE_DESC(v[OFF + 11], v[OFF + 12]);
    CE_DESC(v[OFF + 13], v[OFF + 14]);
    CE_DESC(v[OFF + 0], v[OFF + 8]);
    CE_DESC(v[OFF + 4], v[OFF + 12]);
    CE_DESC(v[OFF + 4], v[OFF + 8]);
    CE_DESC(v[OFF + 2], v[OFF + 10]);
    CE_DESC(v[OFF + 6], v[OFF + 14]);
    CE_DESC(v[OFF + 6], v[OFF + 10]);
    CE_DESC(v[OFF + 2], v[OFF + 4]);
    CE_DESC(v[OFF + 6], v[OFF + 8]);
    CE_DESC(v[OFF + 10], v[OFF + 12]);
    CE_DESC(v[OFF + 1], v[OFF + 9]);
    CE_DESC(v[OFF + 5], v[OFF + 13]);
    CE_DESC(v[OFF + 5], v[OFF + 9]);
    CE_DESC(v[OFF + 3], v[OFF + 11]);
    CE_DESC(v[OFF + 7], v[OFF + 15]);
    CE_DESC(v[OFF + 7], v[OFF + 11]);
    CE_DESC(v[OFF + 3], v[OFF + 5]);
    CE_DESC(v[OFF + 7], v[OFF + 9]);
    CE_DESC(v[OFF + 11], v[OFF + 13]);
    CE_DESC(v[OFF + 1], v[OFF + 2]);
    CE_DESC(v[OFF + 3], v[OFF + 4]);
    CE_DESC(v[OFF + 5], v[OFF + 6]);
    CE_DESC(v[OFF + 7], v[OFF + 8]);
    CE_DESC(v[OFF + 9], v[OFF + 10]);
    CE_DESC(v[OFF + 11], v[OFF + 12]);
    CE_DESC(v[OFF + 13], v[OFF + 14]);
}
template <int A, int B, int N> __device__ __forceinline__ void merge16(float (&v)[N]) {
#pragma unroll
    for (int i = 0; i < 16; ++i) v[A + i] = fmax_s(v[A + i], v[B + 15 - i]);
#pragma unroll
    for (int je = 3; je >= 0; --je) {
#pragma unroll
        for (int i = 0; i < 16; ++i) { const int j = 1 << je, l = i ^ j; if (l > i) CE_DESC(v[A + i], v[A + l]); }
    }
}

__device__ __forceinline__ void p0_transpose_item(const float* W, int K, int N, bf16* WT, int row_off, LAS float* scr, int item, int lane, const float* gain, bool perm_w1 = false) {
    const int nblk = N / 32, kb = item / nblk, nb = item % nblk, k0 = 64 * kb, n0 = 32 * nb;
    if (perm_w1 && n0 >= 1024) { const int np = (n0 - 1024) & 1023, q = np >> 7, i = np & 127; row_off = 1024 + 256 * q + (n0 >= 2048 ? 128 : 0) + i - n0; }
#pragma unroll 8
    for (int i = 0; i < 32; ++i) { const int kk = 2 * i + (lane >> 5); const float g = gain ? gain[k0 + kk] : 1.f; scr[kk * 33 + (lane & 31)] = W[(size_t)(k0 + kk) * N + n0 + (lane & 31)] * g; }
    LDS_WAIT(); asm volatile("" ::: "memory");
    const int c = lane & 7;
#pragma unroll
    for (int j = 0; j < 4; ++j) { const int n = (lane >> 3) + 8 * j; const LAS float* s = scr + (8 * c) * 33 + n;
        v4u o; o.x = pk2(s[0 * 33], s[1 * 33]); o.y = pk2(s[2 * 33], s[3 * 33]); o.z = pk2(s[4 * 33], s[5 * 33]); o.w = pk2(s[6 * 33], s[7 * 33]);
        *(v4u*)(WT + (size_t)(row_off + n0 + n) * K + k0 + 8 * c) = o; }
    LDS_WAIT(); asm volatile("" ::: "memory");
}
__device__ __forceinline__ void p0_fold_item(const float* __restrict__ Wq, const float* __restrict__ SKf, const float* __restrict__ gain, bf16* WT, int item, int lane) {
    const int hp = item >> 7, n0 = 32 * ((item >> 5) & 3), d0 = 32 * (item & 31);
    const int r32 = lane & 31, kh = lane >> 5;
    const float g = gain[d0 + r32];
    const f32x4* ap = (const f32x4*)(SKf + ((size_t)hp * 128 + n0 + r32) * 128 + 16 * kh);
    const f32x4* bp = (const f32x4*)(Wq + (size_t)(d0 + r32) * QPW + hp * 128 + 16 * kh);
    f32x4 a[4][4], b[4][4];
#pragma unroll
    for (int c = 0; c < 4; ++c)
#pragma unroll
        for (int q = 0; q < 4; ++q) { a[c][q] = ap[8 * c + q]; b[c][q] = bp[8 * c + q]; }
    f32x16 acc;
#pragma unroll
    for (int r = 0; r < 16; ++r) acc[r] = 0.f;
#pragma unroll
    for (int c = 0; c < 4; ++c)
#pragma unroll
        for (int q = 0; q < 4; ++q)
#pragma unroll
            for (int e = 0; e < 4; ++e) acc = __builtin_amdgcn_mfma_f32_32x32x2f32(a[c][q][e], b[c][q][e], acc, 0, 0, 0);
#pragma unroll
    for (int r = 0; r < 16; ++r) { const int key = n0 + (r & 3) + 8 * (r >> 2) + 4 * kh; WT[(size_t)(hp * 128 + key) * D + d0 + r32] = (bf16)f2bf(acc[r] * g); }
}
__device__ __forceinline__ float sumsq4(const f32x4 (&v)[4]) { float s = 0.f;
#pragma unroll
    for (int j = 0; j < 4; ++j) s += (v[j].x * v[j].x + v[j].y * v[j].y) + (v[j].z * v[j].z + v[j].w * v[j].w);
    return s; }
__device__ __forceinline__ float absmax4(const f32x4 (&v)[4]) { float mx = 0.f;
#pragma unroll
    for (int j = 0; j < 4; ++j) mx = fmaxf(fmaxf(mx, fmaxf(fabsf(v[j].x), fabsf(v[j].y))), fmaxf(fabsf(v[j].z), fabsf(v[j].w)));
    return mx; }
__device__ __forceinline__ void store_bf16_row(bf16* orow, const f32x4 (&v)[4], float r, int lane) {
    v2u* o8 = (v2u*)orow + lane;
#pragma unroll
    for (int j = 0; j < 4; ++j) o8[64 * j] = (v2u){pk2(v[j].x * r, v[j].y * r), pk2(v[j].z * r, v[j].w * r)};
}
__device__ __forceinline__ void norm_phase(const float* src, bf16* dst, float* RS, int gw, int NGW, int lane) {
    for (int m = gw; m < M; m += 2 * NGW) {
        const int mb = m + NGW; const bool hb = mb < M; const int mbc = hb ? mb : m;
        const f32x4* xa = (const f32x4*)(src + (size_t)m * D) + lane; const f32x4* xb = (const f32x4*)(src + (size_t)mbc * D) + lane;
        f32x4 va[4], vb[4];
#pragma unroll
        for (int j = 0; j < 4; ++j) { va[j] = xa[64 * j]; vb[j] = xb[64 * j]; }
        float sa = sumsq4(va), sb = sumsq4(vb);
#pragma unroll
        for (int o = 1; o < 64; o <<= 1) { sa += __shfl_xor(sa, o); sb += __shfl_xor(sb, o); }
        store_bf16_row(dst + (size_t)m * D, va, 1.f, lane); if (lane == 0) RS[m] = 1.f / sqrtf(sa * (1.f / D) + RMS_EPS);
        if (hb) { store_bf16_row(dst + (size_t)mb * D, vb, 1.f, lane); if (lane == 0) RS[mb] = 1.f / sqrtf(sb * (1.f / D) + RMS_EPS); }
    }
}
__device__ __forceinline__ void cvt_table(const float* src, bf16* dst, size_t n8, const float* gain  , size_t per_layer8, size_t gtid, size_t NT) {
    for (size_t i = gtid; i < n8; i += NT) {
        const f32x4 a = ((const f32x4*)src)[2 * i], b = ((const f32x4*)src)[2 * i + 1];
        f32x4 ga = (f32x4){1.f, 1.f, 1.f, 1.f}, gb = ga;
        if (gain) { const size_t layer = i / per_layer8; const int d0 = (int)((i * 8) % D); ga = *(const f32x4*)(gain + layer * D + d0); gb = *(const f32x4*)(gain + layer * D + d0 + 4); }
        v4u o; o.x = pk2(a.x * ga.x, a.y * ga.y); o.y = pk2(a.z * ga.z, a.w * ga.w); o.z = pk2(b.x * gb.x, b.y * gb.y); o.w = pk2(b.z * gb.z, b.w * gb.w);
        ((v4u*)dst)[i] = o;
    }
}

__device__ __forceinline__ void conv_phase(const bf16* Bb, const bf16* Ub, const float* ck, bf16* Y, int gw, int NGW, int lane) {
    for (int item = gw; item < (M / 16) * 2; item += NGW) {
        const int run = item >> 1, hr = item & 1, t0 = run * 16, d0 = hr * 512 + lane * 8;
        float k0[8], k1[8], k2[8];
#pragma unroll
        for (int q = 0; q < 2; ++q) { const f32x4 a = *(const f32x4*)(ck + d0 + 4 * q), b = *(const f32x4*)(ck + D + d0 + 4 * q), c = *(const f32x4*)(ck + 2 * D + d0 + 4 * q);
#pragma unroll
            for (int e = 0; e < 4; ++e) { k0[4 * q + e] = a[e]; k1[4 * q + e] = b[e]; k2[4 * q + e] = c[e]; } }
        float up2[8], up1[8];
#pragma unroll
        for (int e = 0; e < 8; ++e) { up2[e] = 0.f; up1[e] = 0.f; }
        if ((t0 & (SEQ - 1)) != 0) { const v4u a = *(const v4u*)(Ub + (size_t)(t0 - 2) * D + d0), b = *(const v4u*)(Ub + (size_t)(t0 - 1) * D + d0);
#pragma unroll
            for (int e = 0; e < 4; ++e) { up2[2 * e] = bflo(a[e]); up2[2 * e + 1] = bfhi(a[e]); up1[2 * e] = bflo(b[e]); up1[2 * e + 1] = bfhi(b[e]); } }
#pragma unroll 4
        for (int tt = 0; tt < 16; ++tt) { const v4u b = *(const v4u*)(Bb + (size_t)(t0 + tt) * D + d0), uu = *(const v4u*)(Ub + (size_t)(t0 + tt) * D + d0);
            float u[8], y[8];
#pragma unroll
            for (int e = 0; e < 4; ++e) { u[2 * e] = bflo(uu[e]); u[2 * e + 1] = bfhi(uu[e]); }
#pragma unroll
            for (int e = 0; e < 8; ++e) y[e] = k0[e] * up2[e] + k1[e] * up1[e] + k2[e] * u[e];
            v4u o;
#pragma unroll
            for (int e = 0; e < 4; ++e) o[e] = pk2(bflo(b[e]) * y[2 * e], bfhi(b[e]) * y[2 * e + 1]);
            *(v4u*)(Y + (size_t)(t0 + tt) * D + d0) = o;
#pragma unroll
            for (int e = 0; e < 8; ++e) { up2[e] = up1[e]; up1[e] = u[e]; } }
    }
}

__device__ __forceinline__ float enc_low(float s, unsigned keep_mask, unsigned code) { return __uint_as_float((__float_as_uint(s) & keep_mask) | code); }
__device__ __forceinline__ void sel_load_s(const _Float16* SP, int t0, int h, int p, int r32, int hi, v4u (&sf)[8]) {
    const char* sbase = (const char*)(SP + (size_t)t0 * QPW + h * 256 + p * 128);
    unsigned soff = (unsigned)(r32 * QPW + hi * 64) * 2u; asm volatile("" : "+v"(soff));
#pragma unroll
    for (int c = 0; c < 8; ++c) sf[c] = *(const v4u*)(sbase + (soff + c * 16u));
}
__device__ __forceinline__ void sel_decode(const v4u (&sf)[8], float (&v)[64]) {
    typedef _Float16 h2d __attribute__((ext_vector_type(2)));
#pragma unroll
    for (int i = 0; i < 64; i += 2) { const unsigned wd = sf[i >> 3][(i >> 1) & 3]; const h2d t = __builtin_bit_cast(h2d, wd);
        v[i] = enc_low((float)t.x, 0xFFFFFF80u, (unsigned)(63 - i)); v[i + 1] = enc_low((float)t.y, 0xFFFFFF80u, (unsigned)(62 - i)); }
}
__device__ __forceinline__ void sel_top16(float (&v)[64], unsigned hbit  ) {
    sort16<0>(v); sort16<16>(v); sort16<32>(v); sort16<48>(v);
    merge16<0, 16>(v); merge16<32, 48>(v); merge16<0, 32>(v);
#pragma unroll
    for (int i = 0; i < 16; ++i) { const unsigned x = __float_as_uint(v[i]) | hbit; auto rr = __builtin_amdgcn_permlane32_swap(x, x, false, false); v[i] = __uint_as_float(rr[0]); v[16 + i] = __uint_as_float(rr[1]); }
    merge16<0, 16>(v);
}
typedef _Float16 h2v __attribute__((ext_vector_type(2)));
__device__ __forceinline__ unsigned pkh2(float a, float b) { const h2v t = (h2v){(_Float16)a, (_Float16)b}; return __builtin_bit_cast(unsigned, t); }
__device__ __forceinline__ void sel_finish(const float (&A)[16], const float (&B)[16], int t0, int h, int r32, int hi, unsigned short* IDX, _Float16* GATE) {
    float list[64]; int n = 0;
#pragma unroll
    for (int a = 0; a < 16; ++a)
#pragma unroll
        for (int b = 0; b < 16; ++b) if ((a + 1) * (b + 1) <= 16) { list[n] = enc_low(A[a] + B[b], 0xFFFFFF00u, (unsigned)(a * 16 + b)); ++n; }
#pragma unroll
    for (int i = 50; i < 64; ++i) list[i] = -INFINITY;
    float cv[32];
#pragma unroll
    for (int i = 0; i < 32; ++i) { const float c1 = opq(list[32 + i]), c0 = opq(list[i]); cv[i] = hi ? c1 : c0; }
    sort16<0>(cv); sort16<16>(cv); merge16<0, 16>(cv);
#pragma unroll
    for (int i = 0; i < 16; ++i) { const unsigned x = __float_as_uint(cv[i]); auto rr = __builtin_amdgcn_permlane32_swap(x, x, false, false); cv[i] = __uint_as_float(rr[0]); cv[16 + i] = __uint_as_float(rr[1]); }
    merge16<0, 16>(cv);
    unsigned pA[4], pB[4];
#pragma unroll
    for (int d = 0; d < 4; ++d) { pA[d] = 0u; pB[d] = 0u;
#pragma unroll
        for (int j = 0; j < 4; ++j) { pA[d] |= (127u - (__float_as_uint(A[4 * d + j]) & 127u)) << (8 * j); pB[d] |= (127u - (__float_as_uint(B[4 * d + j]) & 127u)) << (8 * j); } }
    const unsigned qa0 = (unsigned)opq((int)pA[0]), qa1 = (unsigned)opq((int)pA[1]), qa2 = (unsigned)opq((int)pA[2]), qa3 = (unsigned)opq((int)pA[3]);
    const unsigned qb0 = (unsigned)opq((int)pB[0]), qb1 = (unsigned)opq((int)pB[1]), qb2 = (unsigned)opq((int)pB[2]), qb3 = (unsigned)opq((int)pB[3]);
    const float ctop = cv[0];
    unsigned short e8[8]; float g8[8]; float gsum = 0.f;
#pragma unroll
    for (int i = 0; i < 8; ++i) { const float x1 = opq(cv[8 + i]), x0 = opq(cv[i]); const float ck = hi ? x1 : x0;
        const unsigned code = __float_as_uint(ck) & 255u, a = code >> 4, b = code & 15u;
        const unsigned sa = (a & 7u) | 0x0c0c0c00u, sb = (b & 7u) | 0x0c0c0c00u;
        const unsigned a_lo = __builtin_amdgcn_perm(qa1, qa0, sa), a_hi = __builtin_amdgcn_perm(qa3, qa2, sa), b_lo = __builtin_amdgcn_perm(qb1, qb0, sb), b_hi = __builtin_amdgcn_perm(qb3, qb2, sb);
        const unsigned n1 = (a & 8u) ? a_hi : a_lo, n2 = (b & 8u) ? b_hi : b_lo;
        e8[i] = (unsigned short)(n1 * 128u + n2); g8[i] = __expf(ck - ctop); gsum += g8[i]; }
    { const unsigned x = __float_as_uint(gsum); auto rr = __builtin_amdgcn_permlane32_swap(x, x, false, false); gsum += __uint_as_float(hi ? rr[0] : rr[1]); }
    const float ginv = 1.f / gsum;
#pragma unroll
    for (int i = 0; i < 8; ++i) g8[i] *= ginv;
    v4u pe; pe.x = e8[0] | ((unsigned)e8[1] << 16); pe.y = e8[2] | ((unsigned)e8[3] << 16); pe.z = e8[4] | ((unsigned)e8[5] << 16); pe.w = e8[6] | ((unsigned)e8[7] << 16);
    const size_t sbase = (size_t)t0 * 128 + h * 16; const unsigned soff = (unsigned)(r32 * 128 + 8 * hi);
    *(v4u*)((char*)(IDX + sbase) + soff * 2u) = pe;
    *(v4u*)((char*)(GATE + sbase) + soff * 2u) = (v4u){pkh2(g8[0], g8[1]), pkh2(g8[2], g8[3]), pkh2(g8[4], g8[5]), pkh2(g8[6], g8[7])};
}

typedef float f32x2 __attribute__((ext_vector_type(2)));
__device__ __forceinline__ float wave_max(float v) {
#pragma unroll
    for (int o = 1; o < 64; o <<= 1) v = fmaxf(v, __shfl_xor(v, o));
    return v;
}
__device__ __forceinline__ int row16_sum_i(int s) {
    s += __builtin_amdgcn_update_dpp(0, s, 0xB1, 0xF, 0xF, true);
    s += __builtin_amdgcn_update_dpp(0, s, 0x4E, 0xF, 0xF, true);
    s += __builtin_amdgcn_update_dpp(0, s, 0x141, 0xF, 0xF, true);
    s += __builtin_amdgcn_update_dpp(0, s, 0x140, 0xF, 0xF, true);
    return s;
}
__device__ __forceinline__ unsigned pack_i8x4(f32x4 v, float inv) {
    const int a = (int)rintf(v.x * inv), b = (int)rintf(v.y * inv), c = (int)rintf(v.z * inv), d = (int)rintf(v.w * inv);
    return ((unsigned)a & 255u) | (((unsigned)b & 255u) << 8) | (((unsigned)c & 255u) << 16) | (((unsigned)d & 255u) << 24);
}
__device__ __forceinline__ void quant_u_phase(const float* U, const float* gain, unsigned char* Uq, float* su, int gw, int NGW, int lane) {
    for (int row = gw; row < 2 * NEXP; row += NGW) {
        const int layer = row / NEXP;
        const f32x4* ur = (const f32x4*)(U + (size_t)row * D) + 2 * lane; const f32x4* gr = (const f32x4*)(gain + (size_t)layer * D) + 2 * lane;
        f32x4 v[2][2]; float mx = 0.f, ss = 0.f;
#pragma unroll
        for (int j = 0; j < 2; ++j)
#pragma unroll
            for (int h = 0; h < 2; ++h) { v[j][h] = ur[128 * j + h] * gr[128 * j + h]; const f32x4 t = v[j][h];
                mx = fmaxf(fmaxf(mx, fmaxf(fabsf(t.x), fabsf(t.y))), fmaxf(fabsf(t.z), fabsf(t.w))); ss += (t.x * t.x + t.y * t.y) + (t.z * t.z + t.w * t.w); }
        mx = wave_max(mx); ss = wave_sum(ss);
        const float clip = fminf(mx, 2.5f * sqrtf(ss * (1.f / D))); const float sc = clip > 0.f ? clip * (1.f / 7.f) : 1.f, inv = 1.f / sc;
        unsigned* qr = (unsigned*)(Uq + (size_t)row * (D / 2)) + lane;
#pragma unroll
        for (int j = 0; j < 2; ++j) { unsigned w = 0;
#pragma unroll
            for (int e = 0; e < 4; ++e) { const int lo = (int)fminf(fmaxf(rintf(v[j][0][e] * inv), -7.f), 7.f), hi = (int)fminf(fmaxf(rintf(v[j][1][e] * inv), -7.f), 7.f);
                w |= (((unsigned)lo & 15u) | (((unsigned)hi & 15u) << 4)) << (8 * e); }
            qr[64 * j] = w; }
        if (lane == 0) su[row] = sc;
    }
}
__device__ __forceinline__ void quant_v_phase(const float* V, unsigned char* Vq, float* sv, int gw, int NGW, int lane) {
    for (int row = gw; row < 2 * NEXP; row += NGW) {
        const int layer = row / NEXP, e = row % NEXP;
        const f32x4* vr = (const f32x4*)(V + (size_t)row * D) + 4 * lane;
        f32x4 v[4]; float mx = 0.f;
#pragma unroll
        for (int q = 0; q < 4; ++q) { v[q] = vr[q]; mx = fmaxf(fmaxf(mx, fmaxf(fabsf(v[q].x), fabsf(v[q].y))), fmaxf(fabsf(v[q].z), fabsf(v[q].w))); }
        mx = wave_max(mx); const float sc = mx > 0.f ? mx * (1.f / 6.f) : 1.f, inv = 1.f / sc;
        v2u o;
#pragma unroll
        for (int d = 0; d < 2; ++d) { unsigned p = 0u;
            p = __builtin_amdgcn_cvt_scalef32_pk_fp4_f32(p, v[2 * d].x * inv, v[2 * d].y * inv, 1.0f, 0); p = __builtin_amdgcn_cvt_scalef32_pk_fp4_f32(p, v[2 * d].z * inv, v[2 * d].w * inv, 1.0f, 1);
            p = __builtin_amdgcn_cvt_scalef32_pk_fp4_f32(p, v[2 * d + 1].x * inv, v[2 * d + 1].y * inv, 1.0f, 2); p = __builtin_amdgcn_cvt_scalef32_pk_fp4_f32(p, v[2 * d + 1].z * inv, v[2 * d + 1].w * inv, 1.0f, 3);
            o[d] = p; }
        *(v2u*)(Vq + (((size_t)layer * 4 + (lane >> 4)) * NEXP + e) * 128 + (lane & 15) * 8) = o;
        if (lane == 0) sv[row] = sc;
    }
}
__device__ __forceinline__ f32x4 bf4_to_f32(v2u w) { return (f32x4){bflo(w.x), bfhi(w.x), bflo(w.y), bfhi(w.y)}; }
__device__ __forceinline__ void norm_q_store(f32x4 (&v)[4], float ss, float mx, float* rsp, signed char* qrow, float* sxp, int lane) {
    const float r = 1.f / sqrtf(ss * (1.f / D) + RMS_EPS); mx = fminf(mx * r, 2.5f); const float sh = mx > 0.f ? mx * (1.f / 7.f) : 1.f, ih = r / sh;
    const int sft = (lane & 1) ? 4 : 0;
#pragma unroll
    for (int j = 0; j < 4; ++j) { unsigned ph = 0u;
#pragma unroll
        for (int e = 0; e < 4; ++e) { const float qh = fminf(fmaxf(rintf(v[j][e] * ih), -7.f), 7.f); ph |= ((unsigned)(int)qh & 15u) << (8 * e + sft); }
        ph |= (unsigned)__builtin_amdgcn_update_dpp(0, (int)ph, 0xB1, 0xF, 0xF, true);
        if (!(lane & 1)) ((unsigned*)qrow)[(lane >> 1) + 32 * j] = ph; }
    if (lane == 0) { *sxp = sh; *rsp = r; }
}
__device__ __forceinline__ void norm_q_phase(const bf16* src, float* RS, signed char* Xq, float* sx, int gw, int NGW, int lane) {
    for (int m = gw; m < M; m += 2 * NGW) {
        const int mb = m + NGW; const bool hb = mb < M; const int mbc = hb ? mb : m;
        const v2u* xa = (const v2u*)(src + (size_t)m * D) + lane; const v2u* xb = (const v2u*)(src + (size_t)mbc * D) + lane;
        v2u ra[4], rb[4];
#pragma unroll
        for (int j = 0; j < 4; ++j) { ra[j] = xa[64 * j]; rb[j] = xb[64 * j]; }
        f32x4 va[4], vb[4];
#pragma unroll
        for (int j = 0; j < 4; ++j) { va[j] = bf4_to_f32(ra[j]); vb[j] = bf4_to_f32(rb[j]); }
        float sa = sumsq4(va), sb = sumsq4(vb), ma = absmax4(va), mbx = absmax4(vb);
#pragma unroll
        for (int o = 1; o < 64; o <<= 1) { sa += __shfl_xor(sa, o); sb += __shfl_xor(sb, o); ma = fmaxf(ma, __shfl_xor(ma, o)); mbx = fmaxf(mbx, __shfl_xor(mbx, o)); }
        norm_q_store(va, sa, ma, RS + m, Xq + (size_t)m * (D / 2), sx + m, lane);
        if (hb) norm_q_store(vb, sb, mbx, RS + mb, Xq + (size_t)mb * (D / 2), sx + mb, lane);
    }
}
__device__ __forceinline__ void select_phase(const _Float16* SP, unsigned short* IDX, _Float16* GATE, int bx, int G, int wave, int lane) {
    const int h = bx & 7, rank = bx >> 3, nr = (G - h + 7) >> 3;
    const int r32 = lane & 31, hi = lane >> 5;
    const unsigned hbit = hi ? 0u : 64u;
    const int stride = nr * NWAVES; int tile = rank * NWAVES + wave;
    v4u sA[8], sB[8];
    if (tile < M / 32) sel_load_s(SP, tile * 32, h, 0, r32, hi, sA);
    for (; tile < M / 32; tile += stride) {
        const int t0 = tile * 32;
        float v[64], A[16], B[16];
        sel_decode(sA, v);
        sel_load_s(SP, t0, h, 1, r32, hi, sB);
        sel_top16(v, hbit);
#pragma unroll
        for (int i = 0; i < 16; ++i) A[i] = v[i];
        sel_decode(sB, v);
        if (tile + stride < M / 32) sel_load_s(SP, (tile + stride) * 32, h, 0, r32, hi, sA);
        sel_top16(v, hbit);
#pragma unroll
        for (int i = 0; i < 16; ++i) B[i] = v[i];
        sel_finish(A, B, t0, h, r32, hi, IDX, GATE);
    }
}
__device__ __forceinline__ f32x2 gelu2(f32x2 v) {
    const f32x2 av = __builtin_elementwise_abs(v), d = av * 0.2316418882f + 1.0f;
    f32x2 t; t.x = __builtin_amdgcn_rcpf(d.x); t.y = __builtin_amdgcn_rcpf(d.y);
    f32x2 q = t * 0.5307027145f + (-0.7265760135f); q = q * t + 0.7107068705f; q = q * t + (-0.142248368f); q = q * t + 0.127414796f; q = q * t;
    const f32x2 s = (v * v) * (-0.72134752044f);
    f32x2 e; e.x = __builtin_amdgcn_exp2f(s.x); e.y = __builtin_amdgcn_exp2f(s.y);
    const f32x2 m = v * (q * e), r = v - m;
    f32x2 o; o.x = v.x < 0.f ? m.x : r.x; o.y = v.y < 0.f ? m.y : r.y; return o;
}
constexpr int UB = 8, USTEPS = 12;
struct UStep { v4u w[4]; unsigned k; bool v; };
__device__ __forceinline__ void u_issue_step(const unsigned char* Uql, const LAS unsigned* list, int n, int it, int rg, int c8, unsigned emask, UStep& S) {
    const int ent = it * 8 + rg; S.v = ent < n; const unsigned entry = list[S.v ? ent : 0]; S.k = entry >> 16;
    const unsigned char* up = Uql + ((entry & emask) * (unsigned)(D / 2) + 16u * c8);
#pragma unroll
    for (int j = 0; j < 4; ++j) S.w[j] = *(const v4u*)(up + 128 * j);
}
__device__ __forceinline__ void u_compute_step(const UStep& S, const v4u (&xq)[4], LAS float* actl, LAS float* dummy) {
    int a0 = 0, a1 = 0;
#pragma unroll
    for (int j = 0; j < 4; j += 2)
#pragma unroll
        for (int q = 0; q < 4; ++q) { a0 = __builtin_amdgcn_sdot8((int)S.w[j][q], (int)xq[j][q], a0, false); a1 = __builtin_amdgcn_sdot8((int)S.w[j + 1][q], (int)xq[j + 1][q], a1, false); }
    int acc = a0 + a1;
    acc += __builtin_amdgcn_update_dpp(0, acc, 0xB1, 0xF, 0xF, true); acc += __builtin_amdgcn_update_dpp(0, acc, 0x4E, 0xF, 0xF, true); acc += __builtin_amdgcn_update_dpp(0, acc, 0x141, 0xF, 0xF, true);
    LAS float* dst = S.v ? actl + S.k : dummy; *dst = (float)acc;
}
struct UTok { int n; unsigned ea, eb; bool ma, mb; float sua, sva, sub, svb; };
__device__ __forceinline__ void u_prep(const LAS unsigned char* slot, int x, int lane, LAS unsigned* list, const float* sul, const float* svl, bool tv, UTok& T) {
    T.ea = ((const LAS unsigned short*)(slot + 1024))[lane]; T.eb = ((const LAS unsigned short*)(slot + 1024))[64 + lane];
    T.ma = tv && (int)(T.ea >> 12) == x; T.mb = tv && (int)(T.eb >> 12) == x;
    const unsigned long long ba = __ballot(T.ma), bb = __ballot(T.mb);
    const unsigned pa = __builtin_amdgcn_mbcnt_hi((unsigned)(ba >> 32), __builtin_amdgcn_mbcnt_lo((unsigned)ba, 0u)), ca = (unsigned)__popcll(ba);
    const unsigned pb = ca + __builtin_amdgcn_mbcnt_hi((unsigned)(bb >> 32), __builtin_amdgcn_mbcnt_lo((unsigned)bb, 0u));
    if (T.ma) list[pa] = ((unsigned)lane << 16) | T.ea;
    if (T.mb) list[pb] = ((unsigned)(64 + lane) << 16) | T.eb;
    T.n = (int)(ca + (unsigned)__popcll(bb));
    T.sua = 0.f; T.sva = 0.f; T.sub = 0.f; T.svb = 0.f;
    if (T.ma) { T.sua = sul[T.ea]; T.sva = svl[T.ea]; }
    if (T.mb) { T.sub = sul[T.eb]; T.svb = svl[T.eb]; }
}
__device__ __forceinline__ void u_finish(const UTok& T, const LAS unsigned char* slot, float sxt, const LAS float* actl, _Float16* crow, int lane) {
    const LAS _Float16* gl = (const LAS _Float16*)(slot + 1280);
    const f32x2 g = gelu2((f32x2){actl[lane] * T.sua * sxt, actl[64 + lane] * T.sub * sxt});
    if (T.ma) crow[lane] = (_Float16)((float)gl[lane] * g.x * T.sva);
    if (T.mb) crow[64 + lane] = (_Float16)((float)gl[64 + lane] * g.y * T.svb);
}
constexpr int USET = 5;
__device__ __forceinline__ void peer_u_phase(const signed char* Xq, const float* sx, const unsigned short* IDX, const _Float16* GATE, const unsigned char* Uql, const float* sul, const float* svl, _Float16* COEF,
                                             int bx, int G, int wave, int lane, LAS unsigned char* lds, unsigned emask = 0x3fffu) {
    const int x = (bx & 7) >> 1, rank = (bx >> 3) * 2 + (bx & 1), nr = 2 * ((G - (bx & 6) + 7) >> 3);
    const int c8 = lane & 7, rg = lane >> 3;
    LAS unsigned char* wl = lds + wave * 16384;
    LAS unsigned* listA = (LAS unsigned*)(wl + 14336); LAS unsigned* listB = (LAS unsigned*)(wl + 14336 + 512);
    LAS float* actA = (LAS float*)(wl + 14336 + 1024); LAS float* actB = (LAS float*)(wl + 14336 + 1536);
    LAS float* sxl = (LAS float*)(lds + 132096 + wave * 64);
    LAS float* dummy = sxl + 8 + rg;
    const int stride = nr * NWAVES, tfirst = rank * NWAVES + wave, NI = (tfirst < M) ? (M - tfirst + stride - 1) / stride : 0;
    for (int i0 = 0; i0 < NI; i0 += UB) {
        { v4u xr[UB / 2], ir[2], gr[2]; float sxv = 0.f;
#pragma unroll
          for (int h = 0; h < UB / 2; ++h) { const int jj = 2 * h + (lane >> 5); const int tj = tfirst + (i0 + jj < NI ? i0 + jj : NI - 1) * stride; xr[h] = *(const v4u*)(Xq + (size_t)tj * (D / 2) + 16 * (lane & 31)); }
#pragma unroll
          for (int h = 0; h < 2; ++h) { const int jj = 4 * h + (lane >> 4); const int tj = tfirst + (i0 + jj < NI ? i0 + jj : NI - 1) * stride; ir[h] = *(const v4u*)(IDX + (size_t)tj * 128 + 8 * (lane & 15)); }
#pragma unroll
          for (int h = 0; h < 2; ++h) { const int jj = 4 * h + (lane >> 4); const int tj = tfirst + (i0 + jj < NI ? i0 + jj : NI - 1) * stride; gr[h] = *(const v4u*)(GATE + (size_t)tj * 128 + 8 * (lane & 15)); }
          if (lane < UB) { const int tj = tfirst + (i0 + lane < NI ? i0 + lane : NI - 1) * stride; sxv = sx[tj]; }
#pragma unroll
          for (int h = 0; h < UB / 2; ++h) *(LAS v4u*)(wl + 1792 * (2 * h + (lane >> 5)) + 16 * (lane & 31)) = xr[h];
#pragma unroll
          for (int h = 0; h < 2; ++h) *(LAS v4u*)(wl + 1792 * (4 * h + (lane >> 4)) + 1024 + 16 * (lane & 15)) = ir[h];
#pragma unroll
          for (int h = 0; h < 2; ++h) *(LAS v4u*)(wl + 1792 * (4 * h + (lane >> 4)) + 1280 + 16 * (lane & 15)) = gr[h];
          if (lane < UB) sxl[lane] = sxv; }
#pragma unroll 1
        for (int j = 0; j < UB && i0 + j < NI; j += 2) {
            const bool tvB = (j + 1 < UB) && (i0 + j + 1 < NI);
            const LAS unsigned char* slotA = wl + 1792 * j; const LAS unsigned char* slotB = wl + 1792 * (tvB ? j + 1 : j);
            UTok TA, TB;
            u_prep(slotA, x, lane, listA, sul, svl, true, TA);
            u_prep(slotB, x, lane, listB, sul, svl, tvB, TB);
            UStep SA[USET], SB[USET];
#pragma unroll
            for (int u = 0; u < USET; ++u) u_issue_step(Uql, listA, TA.n, u, rg, c8, emask, SA[u]);
#pragma unroll
            for (int u = 0; u < USET; ++u) u_issue_step(Uql, listB, TB.n, u, rg, c8, emask, SB[u]);
            v4u xq[4];
#pragma unroll
            for (int h = 0; h < 4; ++h) xq[h] = *(const LAS v4u*)(slotA + 16 * c8 + 128 * h);
#pragma unroll
            for (int u = 0; u < USET; ++u) u_compute_step(SA[u], xq, actA, dummy);
            for (int it = USET; it * 8 < TA.n; ++it) { UStep t_; u_issue_step(Uql, listA, TA.n, it, rg, c8, emask, t_); u_compute_step(t_, xq, actA, dummy); }
#pragma unroll
            for (int h = 0; h < 4; ++h) xq[h] = *(const LAS v4u*)(slotB + 16 * c8 + 128 * h);
#pragma unroll
            for (int u = 0; u < USET; ++u) u_compute_step(SB[u], xq, actB, dummy);
            for (int it = USET; it * 8 < TB.n; ++it) { UStep t_; u_issue_step(Uql, listB, TB.n, it, rg, c8, emask, t_); u_compute_step(t_, xq, actB, dummy); }
            u_finish(TA, slotA, sxl[j], actA, COEF + (size_t)(tfirst + (i0 + j) * stride) * 128, lane);
            if (tvB) u_finish(TB, slotB, sxl[j + 1], actB, COEF + (size_t)(tfirst + (i0 + j + 1) * stride) * 128, lane);
        }
    }
}
constexpr int VB = 16;
__device__ __forceinline__ void v_issue(const unsigned char* Vs, const LAS unsigned char* slot, unsigned grp, unsigned c8off, v4u (&w)[16]) {
    v4u ev[4];
#pragma unroll
    for (int q = 0; q < 4; ++q) ev[q] = *(const LAS v4u*)(slot + 256 + 64 * grp + 16 * q);
#pragma unroll
    for (int i = 0; i < 16; ++i) { const unsigned off = ev[i >> 2][i & 3]; w[i] = *(const v4u*)(Vs + (off | c8off)); }
}
__device__ __forceinline__ void v_compute_store(const LAS unsigned char* slot, unsigned grp, const v4u (&w)[16], v2u* op, float* sp, bool o8, int lane) {
    const v2u hres = *op;
    __builtin_amdgcn_sched_barrier(0);
    v4u cw[2];
#pragma unroll
    for (int q = 0; q < 2; ++q) cw[q] = *(const LAS v4u*)(slot + 32 * grp + 16 * q);
    typedef _Float16 h2 __attribute__((ext_vector_type(2)));
    h2 ah[16];
#pragma unroll
    for (int i = 0; i < 16; ++i) ah[i] = (h2){(_Float16)0.f, (_Float16)0.f};
#pragma unroll
    for (int i = 0; i < 16; ++i) { const unsigned cpr = cw[i >> 3][(i >> 1) & 3]; const h2 cp = __builtin_bit_cast(h2, cpr); const _Float16 ch = (i & 1) ? cp.y : cp.x; const h2 c = (h2){ch, ch};
#pragma unroll
        for (int q = 0; q < 4; ++q) { const unsigned wv = w[i][q];
            ah[4 * q + 0] += __builtin_amdgcn_cvt_scalef32_pk_f16_fp4(wv, 1.0f, 0) * c; ah[4 * q + 1] += __builtin_amdgcn_cvt_scalef32_pk_f16_fp4(wv, 1.0f, 1) * c;
            ah[4 * q + 2] += __builtin_amdgcn_cvt_scalef32_pk_f16_fp4(wv, 1.0f, 2) * c; ah[4 * q + 3] += __builtin_amdgcn_cvt_scalef32_pk_f16_fp4(wv, 1.0f, 3) * c; } }
    h2 kA[8], kB[4];
#pragma unroll
    for (int f = 0; f < 8; ++f) { auto rr = __builtin_amdgcn_permlane32_swap(__builtin_bit_cast(unsigned, ah[f]), __builtin_bit_cast(unsigned, ah[8 + f]), false, false); kA[f] = __builtin_bit_cast(h2, (unsigned)rr[0]) + __builtin_bit_cast(h2, (unsigned)rr[1]); }
#pragma unroll
    for (int f = 0; f < 4; ++f) { auto rr = __builtin_amdgcn_permlane16_swap(__builtin_bit_cast(unsigned, kA[f]), __builtin_bit_cast(unsigned, kA[4 + f]), false, false); kB[f] = __builtin_bit_cast(h2, (unsigned)rr[0]) + __builtin_bit_cast(h2, (unsigned)rr[1]); }
    float kC[4];
#pragma unroll
    for (int f = 0; f < 2; ++f) { const h2 own = o8 ? kB[2 + f] : kB[f];
        const h2 oth = o8 ? kB[f] : kB[2 + f];
        const h2 got = __builtin_bit_cast(h2, (unsigned)__builtin_amdgcn_update_dpp(0, (int)__builtin_bit_cast(unsigned, oth), 0x128, 0xF, 0xF, true));
        const h2 t = own + got; kC[2 * f] = (float)t.x; kC[2 * f + 1] = (float)t.y; }
    const float o0 = kC[0] + bflo(hres.x), o1 = kC[1] + bfhi(hres.x), o2 = kC[2] + bflo(hres.y), o3 = kC[3] + bfhi(hres.y);
    *op = (v2u){pk2(o0, o1), pk2(o2, o3)};
    float ss = (o0 * o0 + o1 * o1) + (o2 * o2 + o3 * o3);
    ss += __builtin_amdgcn_update_dpp(0.f, ss, 0xB1, 0xF, 0xF, true); ss += __builtin_amdgcn_update_dpp(0.f, ss, 0x4E, 0xF, 0xF, true);
    ss += __builtin_amdgcn_update_dpp(0.f, ss, 0x124, 0xF, 0xF, true); ss += __builtin_amdgcn_update_dpp(0.f, ss, 0x128, 0xF, 0xF, true);
    if ((lane & 15) == 15) sp[lane >> 4] = ss;
}
__device__ __forceinline__ void peer_v_phase(const _Float16* COEF, const unsigned short* IDX, const unsigned char* Vql, bf16* Hres, float* SSQ4, int bx, int G, int wave, int lane, LAS unsigned char* lds) {
    const int s = (bx & 7) >> 1, rank = (bx >> 3) * 2 + (bx & 1), nr = 2 * ((G - (bx & 6) + 7) >> 3);
    const unsigned char* Vs = Vql + (size_t)s * NEXP * 128;
    LAS unsigned char* wl = lds + wave * 16384;
    const LAS unsigned char* zslot = wl + 768 * VB;
    *(LAS v4u*)(wl + 768 * VB + 16 * lane) = (v4u){0u, 0u, 0u, 0u};
    const unsigned grp = (unsigned)(lane >> 3), c8off = (unsigned)(lane & 7) * 16u;
    const bool hi = (lane & 32) != 0, odd = (lane & 16) != 0, o8 = (lane & 8) != 0;
    bf16* Ocol = Hres + s * 256 + 32 * (lane & 7) + (hi ? 16 : 0) + (odd ? 8 : 0) + (o8 ? 4 : 0);
    const int stride = nr * NWAVES, tfirst = rank * NWAVES + wave, NI = (tfirst < M) ? (M - tfirst + stride - 1) / stride : 0;
    for (int i0 = 0; i0 < NI; i0 += VB) {
        { v4u cr[VB / 4], ir[VB / 4];
#pragma unroll
          for (int h = 0; h < VB / 4; ++h) { const int jj = 4 * h + (lane >> 4); const int tj = tfirst + (i0 + jj < NI ? i0 + jj : NI - 1) * stride; cr[h] = *(const v4u*)(COEF + (size_t)tj * 128 + 8 * (lane & 15)); }
#pragma unroll
          for (int h = 0; h < VB / 4; ++h) { const int jj = 4 * h + (lane >> 4); const int tj = tfirst + (i0 + jj < NI ? i0 + jj : NI - 1) * stride; ir[h] = *(const v4u*)(IDX + (size_t)tj * 128 + 8 * (lane & 15)); }
#pragma unroll
          for (int h = 0; h < VB / 4; ++h) *(LAS v4u*)(wl + 768 * (4 * h + (lane >> 4)) + 16 * (lane & 15)) = cr[h];
#pragma unroll
          for (int h = 0; h < VB / 4; ++h) { v4u lo, hi2;
#pragma unroll
              for (int d = 0; d < 2; ++d) { const unsigned x0 = ir[h][d], x1 = ir[h][2 + d];
                  lo[2 * d] = (x0 & 0xffffu) << 7; lo[2 * d + 1] = (x0 >> 16) << 7; hi2[2 * d] = (x1 & 0xffffu) << 7; hi2[2 * d + 1] = (x1 >> 16) << 7; }
              LAS v4u* dst = (LAS v4u*)(wl + 768 * (4 * h + (lane >> 4)) + 256 + 32 * (lane & 15)); dst[0] = lo; dst[1] = hi2; } }
        const int nb = (NI - i0 < VB) ? (NI - i0) : VB;
        v4u wA[16], wB[16];
        v_issue(Vs, wl, grp, c8off, wA);
#pragma unroll 1
        for (int j = 0; j < nb; j += 2) {
            v_issue(Vs, (j + 1 < nb) ? wl + 768 * (j + 1) : zslot, grp, c8off, wB);
            { const int tt = tfirst + (i0 + j) * stride; v_compute_store(wl + 768 * j, grp, wA, (v2u*)(Ocol + (size_t)tt * D), SSQ4 + 16 * (size_t)tt + 4 * s, o8, lane); }
            if (j + 1 >= nb) break;
            v_issue(Vs, (j + 2 < nb) ? wl + 768 * (j + 2) : zslot, grp, c8off, wA);
            { const int tt = tfirst + (i0 + j + 1) * stride; v_compute_store(wl + 768 * (j + 1), grp, wB, (v2u*)(Ocol + (size_t)tt * D), SSQ4 + 16 * (size_t)tt + 4 * s, o8, lane); }
        }
    }
}
__device__ __forceinline__ void final_norm_phase(const bf16* Hb, const float* SSQ4, const float* gfin, float* out, int gw, int NGW, int lane) {
    const f32x4* gr = (const f32x4*)gfin + lane;
    for (int m = gw; m < M; m += 2 * NGW) {
        const int mb = m + NGW; const bool hb = mb < M; const int mbc = hb ? mb : m;
        const v2u* xa = (const v2u*)(Hb + (size_t)m * D) + lane; const v2u* xb = (const v2u*)(Hb + (size_t)mbc * D) + lane;
        v2u ra[4], rb[4];
#pragma unroll
        for (int j = 0; j < 4; ++j) { ra[j] = xa[64 * j]; rb[j] = xb[64 * j]; }
        float ta = 0.f, tb = 0.f;
#pragma unroll
        for (int g = 0; g < 4; ++g) { const f32x4 qa = ((const f32x4*)(SSQ4 + 16 * (size_t)m))[g], qb = ((const f32x4*)(SSQ4 + 16 * (size_t)mbc))[g]; ta += (qa[0] + qa[1]) + (qa[2] + qa[3]); tb += (qb[0] + qb[1]) + (qb[2] + qb[3]); }
        const float rA = 1.f / sqrtf(ta * (1.f / D) + RMS_EPS), rB = 1.f / sqrtf(tb * (1.f / D) + RMS_EPS);
        f32x4* oa = (f32x4*)(out + (size_t)m * D) + lane; f32x4* ob = (f32x4*)(out + (size_t)mbc * D) + lane;
#pragma unroll
        for (int j = 0; j < 4; ++j) { const f32x4 g = gr[64 * j]; oa[64 * j] = bf4_to_f32(ra[j]) * rA * g; if (hb) ob[64 * j] = bf4_to_f32(rb[j]) * rB * g; }
    }
}

template <bool DIAG> __device__ __forceinline__ void attn_tile(const f32x16& s, int qrel  , int hi, float& carry  , v4u (&pa)[2]) {
    float R[16], Bt[16];
#pragma unroll
    for (int r = 0; r < 16; ++r) { const float t = __builtin_amdgcn_exp2f(fminf(s[r], 64.f)); const float rc = __builtin_amdgcn_rcpf(1.f + t), b = t * rc;
        if (DIAG) { const bool causal = ((r & 3) + 8 * (r >> 2) + 4 * hi) < qrel; R[r] = causal ? rc : 1.f; Bt[r] = causal ? b : 0.f; }
        else { R[r] = rc; Bt[r] = b; } }
    float tg[4], og[4];
#pragma unroll
    for (int g = 0; g < 4; ++g) { tg[g] = (R[4 * g] * R[4 * g + 1]) * (R[4 * g + 2] * R[4 * g + 3]);
        const unsigned x = __float_as_uint(tg[g]); auto rr = __builtin_amdgcn_permlane32_swap(x, x, false, false); og[g] = __uint_as_float(hi ? rr[0] : rr[1]); }
    float base[4]; float run = carry;
#pragma unroll
    for (int g = 3; g >= 0; --g) { base[g] = hi ? run : run * og[g]; run *= tg[g] * og[g]; }
    float w[16];
#pragma unroll
    for (int g = 0; g < 4; ++g) { float a = base[g];
#pragma unroll
        for (int i = 3; i >= 0; --i) { w[4 * g + i] = Bt[4 * g + i] * a; a *= R[4 * g + i]; } }
    carry = run;
#pragma unroll
    for (int s2 = 0; s2 < 2; ++s2) { pa[s2].x = pg8::cvt_pk_bf16(w[8 * s2], w[8 * s2 + 1]); pa[s2].y = pg8::cvt_pk_bf16(w[8 * s2 + 2], w[8 * s2 + 3]); pa[s2].z = pg8::cvt_pk_bf16(w[8 * s2 + 4], w[8 * s2 + 5]); pa[s2].w = pg8::cvt_pk_bf16(w[8 * s2 + 6], w[8 * s2 + 7]); }
}
__device__ __forceinline__ void attn_phase(const bf16* Q, const bf16* K, const bf16* V, bf16* O, int vcu, int G, int wave, int lane, LAS unsigned char* lds) {
    const int r32 = lane & 31, hi = lane >> 5;
    LAS unsigned char* vt = lds + wave * 8192;
    const unsigned vt_addr = (unsigned)(uintptr_t)vt;
    const unsigned tr_base = vt_addr + (unsigned)((4 * hi + ((lane & 15) >> 2)) * 128 + (16 * ((lane >> 4) & 1) + 4 * (lane & 3)) * 2);
    for (int wu = vcu; wu < NB * NH * (SEQ / 512); wu += G) {
        const int bh = wu / (SEQ / 512), qbA = ((wu % (SEQ / 512)) * 8 + wave) * 2, qbB = qbA + 1, b = bh / NH, h = bh % NH;
        const size_t rowbase = (size_t)b * SEQ; const int q0 = qbA * 32;
        bf16x8 qfA[4], qfB[4];
        { const bf16* Qw = Q + (rowbase + q0 + r32) * D + h * HD + hi * 8;
#pragma unroll
          for (int ks = 0; ks < 4; ++ks) { qfA[ks] = *(const bf16x8*)(Qw + ks * 16); qfB[ks] = *(const bf16x8*)(Qw + (size_t)32 * D + ks * 16); } }
        f32x16 oA0, oA1, oB0, oB1;
#pragma unroll
        for (int r = 0; r < 16; ++r) { oA0[r] = 0.f; oA1[r] = 0.f; oB0[r] = 0.f; oB1[r] = 0.f; }
        float carryA = 1.f, carryB = 1.f;
        bf16x8 k0[4], k1[4];
        { const bf16* Kw = K + (rowbase + (size_t)qbB * 32 + r32) * D + h * HD + hi * 8;
          v4u vfirst[4];
#pragma unroll
          for (int ks = 0; ks < 4; ++ks) k0[ks] = *(const bf16x8*)(Kw + ks * 16);
#pragma unroll
          for (int i = 0; i < 4; ++i) vfirst[i] = *(const v4u*)(V + (rowbase + (size_t)qbB * 32 + (lane >> 3) + 8 * i) * D + h * HD + (lane & 7) * 8);
#pragma unroll
          for (int i = 0; i < 4; ++i) *(LAS v4u*)(vt + ((lane >> 3) + 8 * i) * 128 + (lane & 7) * 16) = vfirst[i]; }
        auto tile = [&](auto mode, auto cur, int kt, const bf16x8 (&kc)[4], bf16x8 (&kn)[4]) __attribute__((always_inline)) -> bool {
            constexpr int MODE = decltype(mode)::value, CUR = decltype(cur)::value;
            v4u vnx[4];
            if (kt > 0) { const bf16* Kw = K + (rowbase + (size_t)(kt - 1) * 32 + r32) * D + h * HD + hi * 8;
#pragma unroll
                for (int ks = 0; ks < 4; ++ks) kn[ks] = *(const bf16x8*)(Kw + ks * 16);
#pragma unroll
                for (int i = 0; i < 4; ++i) vnx[i] = *(const v4u*)(V + (rowbase + (size_t)(kt - 1) * 32 + (lane >> 3) + 8 * i) * D + h * HD + (lane & 7) * 8); }
            f32x16 sB;
#pragma unroll
            for (int r = 0; r < 16; ++r) sB[r] = 0.f;
#pragma unroll
            for (int ks = 0; ks < 4; ++ks) sB = __builtin_amdgcn_mfma_f32_32x32x16_bf16(kc[ks], qfB[ks], sB, 0, 0, 0);
            v4u paB[2], paA[2];
            attn_tile<MODE == 0>(sB, r32, hi, carryB, paB);
            __builtin_amdgcn_sched_barrier(0);
            if (MODE >= 1) { f32x16 sA;
#pragma unroll
                for (int r = 0; r < 16; ++r) sA[r] = 0.f;
#pragma unroll
                for (int ks = 0; ks < 4; ++ks) sA = __builtin_amdgcn_mfma_f32_32x32x16_bf16(kc[ks], qfA[ks], sA, 0, 0, 0);
                attn_tile<MODE == 1>(sA, r32, hi, carryA, paA); }
            LDS_WAIT();
            __builtin_amdgcn_sched_barrier(0);
            s16x4 vlo[2][2], vhi[2][2];
#pragma unroll
            for (int s2 = 0; s2 < 2; ++s2)
#pragma unroll
                for (int db = 0; db < 2; ++db) {
                    asm volatile("ds_read_b64_tr_b16 %0, %1 offset:%c2" : "=v"(vlo[s2][db]) : "v"(tr_base), "i"(CUR * 4096 + s2 * 16 * 128 + db * 64) : "memory");
                    asm volatile("ds_read_b64_tr_b16 %0, %1 offset:%c2" : "=v"(vhi[s2][db]) : "v"(tr_base), "i"(CUR * 4096 + s2 * 16 * 128 + 8 * 128 + db * 64) : "memory"); }
            asm volatile("s_waitcnt lgkmcnt(0)" : "+v"(vlo[0][0]), "+v"(vlo[0][1]), "+v"(vlo[1][0]), "+v"(vlo[1][1]), "+v"(vhi[0][0]), "+v"(vhi[0][1]), "+v"(vhi[1][0]), "+v"(vhi[1][1]) :: "memory");
            __builtin_amdgcn_sched_barrier(0);
#pragma unroll
            for (int s2 = 0; s2 < 2; ++s2) {
                const bf16x8 v0 = (bf16x8){vlo[s2][0][0], vlo[s2][0][1], vlo[s2][0][2], vlo[s2][0][3], vhi[s2][0][0], vhi[s2][0][1], vhi[s2][0][2], vhi[s2][0][3]};
                const bf16x8 v1 = (bf16x8){vlo[s2][1][0], vlo[s2][1][1], vlo[s2][1][2], vlo[s2][1][3], vhi[s2][1][0], vhi[s2][1][1], vhi[s2][1][2], vhi[s2][1][3]};
                const bf16x8 pB = __builtin_bit_cast(bf16x8, paB[s2]);
                oB0 = __builtin_amdgcn_mfma_f32_32x32x16_bf16(pB, v0, oB0, 0, 0, 0);
                oB1 = __builtin_amdgcn_mfma_f32_32x32x16_bf16(pB, v1, oB1, 0, 0, 0);
                if (MODE >= 1) { const bf16x8 pA = __builtin_bit_cast(bf16x8, paA[s2]);
                    oA0 = __builtin_amdgcn_mfma_f32_32x32x16_bf16(pA, v0, oA0, 0, 0, 0);
                    oA1 = __builtin_amdgcn_mfma_f32_32x32x16_bf16(pA, v1, oA1, 0, 0, 0); }
            }
            if (kt > 0) {
#pragma unroll
                for (int i = 0; i < 4; ++i) *(LAS v4u*)(vt + (1 - CUR) * 4096 + ((lane >> 3) + 8 * i) * 128 + (lane & 7) * 16) = vnx[i]; }
            return MODE >= 1 && __all(fmaxf(carryA, carryB) < 1e-37f);
        };
        using I0 = std::integral_constant<int, 0>; using I1 = std::integral_constant<int, 1>; using I2 = std::integral_constant<int, 2>;
        (void)tile(I0{}, I0{}, qbB, k0, k1);
        bool done = tile(I1{}, I1{}, qbA, k1, k0);
        for (int kt = qbA - 1; !done && kt >= 0; kt -= 2) {
            done = tile(I2{}, I0{}, kt, k0, k1);
            if (done || kt == 0) break;
            done = tile(I2{}, I1{}, kt - 1, k1, k0);
        }
        LDS_WAIT();
#pragma unroll
        for (int r = 0; r < 16; ++r) { const int qr = (r & 3) + 8 * (r >> 2) + 4 * hi;
            *(LAS bf16*)(vt + qr * 128 + r32 * 2) = (bf16)f2bf(oA0[r]); *(LAS bf16*)(vt + qr * 128 + 64 + r32 * 2) = (bf16)f2bf(oA1[r]);
            *(LAS bf16*)(vt + 4096 + qr * 128 + r32 * 2) = (bf16)f2bf(oB0[r]); *(LAS bf16*)(vt + 4096 + qr * 128 + 64 + r32 * 2) = (bf16)f2bf(oB1[r]); }
        LDS_WAIT();
        { bf16* Ow = O + (rowbase + q0 + (lane >> 3)) * D + h * HD + (lane & 7) * 8;
#pragma unroll
          for (int i = 0; i < 8; ++i) *(v4u*)(Ow + (size_t)(8 * i) * D) = *(const LAS v4u*)(vt + ((lane >> 3) + 8 * i) * 128 + (lane & 7) * 16); }
        LDS_WAIT();
    }
}

#ifndef MK_N_LAUNCHES
#define MK_N_LAUNCHES 1
#endif
constexpr int N_PHASES = 19;
constexpr int N_LAUNCHES = MK_N_LAUNCHES;
static_assert(N_LAUNCHES == 1 || N_LAUNCHES == N_PHASES, "MK_N_LAUNCHES is 1 or 19");
enum { IN_X = 0, IN_NORM_MIX, IN_NORM_FFN, IN_CONV_W_IN, IN_CONV_K, IN_CONV_W_OUT, IN_NORM_KV, IN_W_KV, IN_ATTN_WQ, IN_ATTN_WO, IN_PEER_WQ, IN_PEER_SK, IN_PEER_U, IN_PEER_V, IN_NORM_FINAL, N_IN };
struct Args { const float* in[N_IN]; float* out; unsigned char* ws; int ph_lo, ph_hi; };

__global__ void __launch_bounds__(NWAVES * 64, 2) fwd_kernel(Args args) {
    extern __shared__ __attribute__((aligned(16))) unsigned char lds_raw[];
    LAS unsigned char* lds = (LAS unsigned char*)lds_raw;
    volatile LAS unsigned* MISC = (volatile LAS unsigned*)(lds + MISC_OFF);
    const int tid = threadIdx.x, lane = tid & 63, wave = __builtin_amdgcn_readfirstlane(tid >> 6);
    const int G = gridDim.x, bx = blockIdx.x;
    const int vcu = (G % 8 == 0) ? (bx % 8) * (G / 8) + bx / 8 : bx;
    const int gw = vcu * NWAVES + wave, NGW = G * NWAVES;
    unsigned char* ws = args.ws;
    gu32* ctl = (gu32*)(ws + WS_CTL);
    bf16* W1 = (bf16*)(ws + WS_W1); bf16* W2 = (bf16*)(ws + WS_W2); bf16* WQ0 = (bf16*)(ws + WS_WQ0); bf16* WQKV = (bf16*)(ws + WS_WQKV); bf16* WO = (bf16*)(ws + WS_WO); bf16* WQ1 = (bf16*)(ws + WS_WQ1);
    bf16* SK = (bf16*)(ws + WS_SK); bf16* XN = (bf16*)(ws + WS_XN); bf16* BIG = (bf16*)(ws + WS_BIG);
    unsigned char* UQ = ws + WS_UQ; unsigned char* VQ = ws + WS_VQ; float* SU = (float*)(ws + WS_SU); float* SV = (float*)(ws + WS_SV);
    signed char* XQ = (signed char*)(ws + WS_XQ); float* SX = (float*)(ws + WS_SX); float* RS = (float*)(ws + WS_SX + 512 * 1024); unsigned short* IDX = (unsigned short*)(ws + WS_IDX); _Float16* GATE = (_Float16*)(ws + WS_GATE); _Float16* COEF = (_Float16*)(ws + WS_ACT); float* SSQ4 = (float*)(ws + WS_SSQ4);
    bf16* Hb = (bf16*)(ws + WS_HB);
    for (int u = tid; u < (LDS_BYTES - LDSCTL_OFF) / 4; u += NWAVES * 64) ((LAS unsigned*)(lds + LDSCTL_OFF))[u] = 0u;
    __syncthreads();
    XcdBarrier bar; bar.bar = (unsigned*)(ctl + CW_BAR); bar.x = 0; bar.st = nullptr;
    if (N_LAUNCHES == 1) bar = xcd_barrier_post((unsigned*)(ctl + CW_BAR), MISC + 8);
    const int lo = args.ph_lo, hi = args.ph_hi;
#define PEER_BX bx
#define PEER_G  G
#define IN(k) (lo <= (k) && (k) < hi)
#define SEAM(k) do { if (IN(k) && IN((k) + 1)) xcd_barrier(bar); } while (0)

    if (IN(0)) {
        LAS float* scr = (LAS float*)(lds + RING_OFF + wave * 16384);
        constexpr int I_W1 = 16 * 96, I_W2 = 16 * 32, I_Q = 16 * 64, I_AQ = 16 * 32, I_KV = 16 * 64, I_O = 16 * 32;
        constexpr int I_F = 16 * 4 * 32;
        constexpr int NITEMS = 2 * I_F + I_W1 + I_W2 + I_AQ + I_KV + I_O;
        for (int it = gw; it < NITEMS; it += NGW) {
            int r = it;
            if (r < 2 * I_F) { const int ly = r / I_F; p0_fold_item(args.in[IN_PEER_WQ] + (size_t)ly * D * QPW, args.in[IN_PEER_SK] + (size_t)ly * PH * 2 * NKEYS * KD, args.in[IN_NORM_FFN] + (size_t)ly * D, ly ? WQ1 : WQ0, r % I_F, lane); continue; } r -= 2 * I_F;
            if (r < I_W1) { p0_transpose_item(args.in[IN_CONV_W_IN], D, 3 * D, W1, 0, scr, r, lane, args.in[IN_NORM_MIX], true); continue; } r -= I_W1;
            if (r < I_W2) { p0_transpose_item(args.in[IN_CONV_W_OUT], D, D, W2, 0, scr, r, lane, nullptr); continue; } r -= I_W2;
            if (r < I_AQ) { p0_transpose_item(args.in[IN_ATTN_WQ], D, D, WQKV, 0, scr, r, lane, args.in[IN_NORM_MIX] + D); continue; } r -= I_AQ;
            if (r < I_KV) { p0_transpose_item(args.in[IN_W_KV], D, 2 * D, WQKV, D, scr, r, lane, args.in[IN_NORM_KV]); continue; } r -= I_KV;
            p0_transpose_item(args.in[IN_ATTN_WO], D, D, WO, 0, scr, r, lane, nullptr);
        }
        const size_t gtid = (size_t)vcu * (NWAVES * 64) + tid, NT = (size_t)G * (NWAVES * 64);
        quant_u_phase(args.in[IN_PEER_U], args.in[IN_NORM_FFN], UQ, SU, gw, NGW, lane);
        quant_v_phase(args.in[IN_PEER_V], VQ, SV, gw, NGW, lane);
        norm_phase(args.in[IN_X], Hb, RS, gw, NGW, lane);
    }
    SEAM(0);
    if (IN(1)) {
        pg8::Gemm g{Hb, W1, M, 3 * D, D}; pg8::StaticOrder S; S.init(M, 3 * D, G, bx);
        pg8::EpiConvIn E{BIG, BIG + (size_t)M * D, RS};
        pg8::gemm_phase<pg8::EpiConvIn, pg8::StaticOrder, true, true>(lds + RING_OFF, g, S, E);
    }
    SEAM(1);
    if (IN(2)) conv_phase(BIG, BIG + (size_t)M * D, args.in[IN_CONV_K], XN, gw, NGW, lane);
    SEAM(2);
    if (IN(3)) {
        pg8::Gemm g{XN, W2, M, D, D}; pg8::StaticOrder S; S.init(M, D, G, bx);
        pg8::EpiBf16Res<false> E{Hb, Hb, D};
        pg8::gemm_phase<pg8::EpiBf16Res<false>, pg8::StaticOrder, true, true>(lds + RING_OFF, g, S, E);
    }
    SEAM(3);
    if (IN(4)) norm_q_phase(Hb, RS, XQ, SX, gw, NGW, lane);
    SEAM(4);
    if (IN(5)) {
        pg8::Gemm g{Hb, WQ0, M, QPW, D}; pg8::StaticOrder S; S.init(M, QPW, G, bx);
        pg8::EpiBf16 E{BIG, QPW, 0, 0, 1.f, RS, 0, 1};
        pg8::gemm_phase<pg8::EpiBf16, pg8::StaticOrder, true, true>(lds + RING_OFF, g, S, E);
    }
    SEAM(5);
    if (IN(6)) select_phase((const _Float16*)BIG, IDX, GATE, bx, G, wave, lane);
    SEAM(6);
    if (IN(7)) peer_u_phase(XQ, SX, IDX, GATE, UQ, SU, SV, COEF, PEER_BX, PEER_G, wave, lane, lds + RING_OFF);
    SEAM(7);
    if (IN(8)) peer_v_phase(COEF, IDX, VQ, Hb, SSQ4, PEER_BX, PEER_G, wave, lane, lds + RING_OFF);
    SEAM(8);
    if (IN(10)) {
        pg8::Gemm g{Hb, WQKV, M, 3 * D, D}; pg8::StaticOrder S; S.init(M, 3 * D, G, bx);
        pg8::EpiBf16 E{BIG, D, D, (size_t)M * D, 0.125f * 1.4426950408889634f, SSQ4, 1, 0};
        pg8::gemm_phase<pg8::EpiBf16, pg8::StaticOrder, true, true>(lds + RING_OFF, g, S, E);
    }
    SEAM(10);
    if (IN(11)) attn_phase(BIG, BIG + (size_t)M * D, BIG + (size_t)2 * M * D, XN, vcu, G, wave, lane, lds + RING_OFF);
    SEAM(11);
    if (IN(12)) {
        pg8::Gemm g{XN, WO, M, D, D}; pg8::StaticOrder S; S.init(M, D, G, bx);
        pg8::EpiBf16Res<false> E{Hb, Hb, D};
        pg8::gemm_phase<pg8::EpiBf16Res<false>, pg8::StaticOrder, true, true>(lds + RING_OFF, g, S, E);
    }
    SEAM(12);
    if (IN(13)) norm_q_phase(Hb, RS, XQ, SX, gw, NGW, lane);
    SEAM(13);
    if (IN(14)) {
        pg8::Gemm g{Hb, WQ1, M, QPW, D}; pg8::StaticOrder S; S.init(M, QPW, G, bx);
        pg8::EpiBf16 E{BIG, QPW, 0, 0, 1.f, RS, 0, 1};
        pg8::gemm_phase<pg8::EpiBf16, pg8::StaticOrder, true, true>(lds + RING_OFF, g, S, E);
    }
    SEAM(14);
    if (IN(15)) select_phase((const _Float16*)BIG, IDX, GATE, bx, G, wave, lane);
    SEAM(15);
    if (IN(16)) peer_u_phase(XQ, SX, IDX, GATE, UQ + (size_t)NEXP * (D / 2), SU + NEXP, SV + NEXP, COEF, PEER_BX, PEER_G, wave, lane, lds + RING_OFF);
    SEAM(16);
    if (IN(17)) peer_v_phase(COEF, IDX, VQ + (size_t)4 * NEXP * 128, Hb, SSQ4, PEER_BX, PEER_G, wave, lane, lds + RING_OFF);
    SEAM(17);
    if (IN(18)) final_norm_phase(Hb, SSQ4, args.in[IN_NORM_FINAL], args.out, gw, NGW, lane);
#undef IN
#undef SEAM
}

extern "C" void kernel_launch(void* const* d_in, const int* in_sizes, int n_in, void* d_out, int out_size, void* d_ws, size_t ws_size, hipStream_t stream) {
    static int grid = 0;
    if (grid == 0) {
        if (n_in != N_IN || in_sizes[0] != M * D || out_size != M * D || ws_size < WS_END) { fprintf(stderr, "kernel_launch: unexpected shapes (n_in %d, in0 %d, out %d, ws %zu); nothing launched\n", n_in, n_in > 0 ? in_sizes[0] : -1, out_size, ws_size); grid = -1; return; }
        int dev = 0, cus = 0, per_cu = 0;
        if (hipGetDevice(&dev) != hipSuccess || hipDeviceGetAttribute(&cus, hipDeviceAttributeMultiprocessorCount, dev) != hipSuccess) { fprintf(stderr, "kernel_launch: device query failed\n"); grid = -1; return; }
        if (hipFuncSetAttribute((const void*)fwd_kernel, hipFuncAttributeMaxDynamicSharedMemorySize, LDS_BYTES) != hipSuccess) { fprintf(stderr, "kernel_launch: hipFuncSetAttribute failed\n"); grid = -1; return; }
        if (hipOccupancyMaxActiveBlocksPerMultiprocessor(&per_cu, (const void*)fwd_kernel, NWAVES * 64, LDS_BYTES) != hipSuccess || per_cu < 1) fprintf(stderr, "kernel_launch: note: occupancy query reports %d workgroups per CU\n", per_cu);
        (void)hipGetLastError();
        grid = cus - (cus % 8);
        if (grid < 8) { fprintf(stderr, "kernel_launch: needs at least 8 workgroups\n"); grid = -1; return; }
    }
    if (grid < 0) return;
    if (hipMemsetAsync((char*)d_ws + WS_CTL, 0, CTL_ZERO_BYTES, stream) != hipSuccess) { fprintf(stderr, "kernel_launch: hipMemsetAsync failed\n"); return; }
    Args a{};
    for (int i = 0; i < N_IN; ++i) a.in[i] = (const float*)d_in[i];
    a.out = (float*)d_out; a.ws = (unsigned char*)d_ws;
    for (int li = 0; li < N_LAUNCHES; ++li) {
        a.ph_lo = (N_LAUNCHES == 1) ? 0 : li; a.ph_hi = (N_LAUNCHES == 1) ? N_PHASES : li + 1;
        hipLaunchKernelGGL(fwd_kernel, dim3(grid), dim3(NWAVES * 64), LDS_BYTES, stream, a);
        const hipError_t le = hipPeekAtLastError();
        if (le != hipSuccess) { fprintf(stderr, "kernel_launch: launch %d failed: %s\n", li, hipGetErrorName(le)); break; }
    }
}
```
